# Optimizing an MI355X kernel written in HIP

```python
import math
import functools
import jax
import jax.numpy as jnp
from jax import lax
import numpy as np

D_MODEL = 2048
BATCH = 4
SEQ = 4096
DEPTH = 2

GRID_W = 64
CTX_LEN = 256
CHUNK = 64
CONV_K = 3
N_MOD = 9
N_BRANCH = 3
D_FF = 11 * D_MODEL // 4
SSD_HEAD_DIM = 64
SSD_INNER = D_MODEL // 2
SSD_HEADS = SSD_INNER // SSD_HEAD_DIM
SSD_GROUPS = 4
SSD_HPG = SSD_HEADS // SSD_GROUPS
SSD_STATE = 64
SSD_XBC = SSD_INNER + 2 * SSD_GROUPS * SSD_STATE
ML_WIDTH = D_MODEL // 4
ML_HEADS = 4
ML_HEAD_DIM = ML_WIDTH // ML_HEADS
GLA_WIDTH = D_MODEL // 4
GLA_HEADS = 4
GLA_DV = GLA_WIDTH // GLA_HEADS
GLA_KEY_WIDTH = GLA_WIDTH // 2
GLA_DK = GLA_KEY_WIDTH // GLA_HEADS
GLA_RANK = 16
GLA_TAU = 16.0
DEEPNORM_ALPHA = (2 * DEPTH) ** 0.25
DEEPNORM_BETA = (8 * DEPTH) ** -0.25
EPS = 1e-5
IN_SIZES = (SSD_INNER, SSD_XBC, 2 * SSD_HEADS,
            ML_WIDTH, ML_WIDTH, ML_WIDTH, ML_WIDTH, 4 * ML_HEADS,
            GLA_KEY_WIDTH, GLA_KEY_WIDTH, GLA_WIDTH, GLA_WIDTH, 2 * GLA_RANK,
            N_BRANCH * D_MODEL)
IN_TOTAL = sum(IN_SIZES)

kernel_name = 'hybrid_ssd_mlstm_gla_diffusion_block'


def _split(t, sizes):
    idx = [int(s) for s in np.cumsum(sizes)[:-1]]
    return jnp.split(t, idx, axis=-1)


def _chunks(t):
    return t.reshape(t.shape[0], t.shape[1] // CHUNK, CHUNK, *t.shape[2:])


def _causal_mask():
    return jnp.tril(jnp.ones((CHUNK, CHUNK), dtype=bool))


def layer_norm(x, g, b):
    xf = x.astype(jnp.float32)
    mu = jnp.mean(xf, axis=-1, keepdims=True)
    var = jnp.mean(jnp.square(xf - mu), axis=-1, keepdims=True)
    return ((xf - mu) * lax.rsqrt(var + EPS)).astype(x.dtype) * g + b


def group_norm(y, w, groups, center):
    shp = y.shape
    yf = y.astype(jnp.float32).reshape(*shp[:-1], groups, shp[-1] // groups)
    if center:
        yf = yf - jnp.mean(yf, axis=-1, keepdims=True)
    yf = yf * lax.rsqrt(jnp.mean(jnp.square(yf), axis=-1, keepdims=True) + EPS)
    return yf.reshape(shp).astype(y.dtype) * w


def swiglu(u, w_in, w_out):
    a, g = jnp.split(u @ w_in, 2, axis=-1)
    return (jax.nn.silu(g) * a) @ w_out


def short_conv(u, uc, w, b):
    bsz, T, ch = u.shape
    rows = T // GRID_W
    grid = u.reshape(bsz, rows, GRID_W, ch)
    y = lax.conv_general_dilated(grid, w[:, :, None, :], window_strides=(1, 1), padding='SAME',
                                 dimension_numbers=('NHWC', 'HWIO', 'NHWC'), feature_group_count=ch)
    yc = lax.conv_general_dilated(uc, w[1][:, None, :], window_strides=(1,), padding='SAME',
                                  dimension_numbers=('NWC', 'WIO', 'NWC'), feature_group_count=ch)
    return y.reshape(bsz, T, ch) + b, yc + b


def ssd_chunked(x, dt, bm, cm, state, need_out, a):
    out_dtype = x.dtype
    bsz, T = x.shape[:2]
    x, dt, bm, cm = (_chunks(t.astype(jnp.float32)) for t in (x, dt, bm, cm))
    acum = jnp.cumsum(dt * a, axis=2)
    a_end = acum[:, :, -1]
    w_end = jnp.exp(a_end[:, :, None] - acum) * dt
    s_loc = jnp.einsum('bclgn,bclgh,bclghp->bcghpn', bm, w_end, x)

    def step(h, inp):
        dec, s = inp
        return h * jnp.exp(dec)[..., None, None] + s, h

    h_fin, h_in = lax.scan(step, state, (jnp.moveaxis(a_end, 1, 0), jnp.moveaxis(s_loc, 1, 0)))
    if not need_out:
        return None, h_fin
    h_in = jnp.moveaxis(h_in, 0, 1)
    seg = acum[:, :, :, None] - acum[:, :, None, :]
    decay = jnp.exp(jnp.where(_causal_mask()[:, :, None, None], seg, -jnp.inf))
    cb = jnp.einsum('bclgn,bcsgn->bclsg', cm, bm)
    y = jnp.einsum('bclsg,bclsgh,bcsgh,bcsghp->bclghp', cb, decay, dt, x)
    y = y + jnp.einsum('bclgn,bcghpn,bclgh->bclghp', cm, h_in, jnp.exp(acum))
    return y.reshape(bsz, T, *y.shape[3:]).astype(out_dtype), h_fin


def mlstm_chunked(q, k, v, i_pre, f_pre, state, need_out):
    out_dtype = v.dtype
    bsz, T = v.shape[:2]
    q, k, v, ig, fg = (_chunks(t.astype(jnp.float32)) for t in (q, k, v, i_pre, f_pre))
    q = q * (ML_HEAD_DIM ** -0.5)
    b = jnp.cumsum(jax.nn.log_sigmoid(fg), axis=2)
    b_end = b[:, :, -1]
    a = b_end[:, :, None] - b + ig
    m_loc = jnp.max(a, axis=2)
    w = jnp.exp(a - m_loc[:, :, None])
    c_loc = jnp.einsum('bcjh,bcjhv,bcjhk->bchvk', w, v, k)
    n_loc = jnp.einsum('bcjh,bcjhk->bchk', w, k)

    def step(carry, inp):
        c_st, n_st, m_st = carry
        be, ml, cl, nl = inp
        m_new = jnp.maximum(be + m_st, ml)
        f_old = jnp.exp(be + m_st - m_new)
        f_new = jnp.exp(ml - m_new)
        new = (f_old[..., None, None] * c_st + f_new[..., None, None] * cl,
               f_old[..., None] * n_st + f_new[..., None] * nl,
               m_new)
        return new, carry

    fin, ent = lax.scan(step, state, tuple(jnp.moveaxis(t, 1, 0) for t in (b_end, m_loc, c_loc, n_loc)))
    if not need_out:
        return None, fin
    c_in, n_in, m_in = (jnp.moveaxis(t, 0, 1) for t in ent)
    dmat = b[:, :, :, None, :] - b[:, :, None, :, :] + ig[:, :, None, :, :]
    dmat = jnp.where(_causal_mask()[:, :, None], dmat, -jnp.inf)
    g = b + m_in[:, :, None, :]
    m_t = jnp.maximum(jnp.max(dmat, axis=3), g)
    s = jnp.exp(dmat - m_t[:, :, :, None, :]) * jnp.einsum('bcthk,bcjhk->bctjh', q, k)
    g_w = jnp.exp(g - m_t)
    num = jnp.einsum('bctjh,bcjhv->bcthv', s, v) + g_w[..., None] * jnp.einsum('bcthk,bchvk->bcthv', q, c_in)
    den = jnp.sum(s, axis=3) + g_w * jnp.einsum('bcthk,bchk->bcth', q, n_in)
    h = num / jnp.maximum(jnp.abs(den), jnp.exp(-m_t))[..., None]
    return h.reshape(bsz, T, *h.shape[3:]).astype(out_dtype), fin


def gla_chunked(q, k, v, log_a, state, need_out):
    out_dtype = v.dtype
    bsz, T = v.shape[:2]
    q, k, v, log_a = (_chunks(t.astype(jnp.float32)) for t in (q, k, v, log_a))
    q = q * (GLA_DK ** -0.5)
    b = jnp.cumsum(log_a, axis=2)
    b_end = b[:, :, -1]
    s_loc = jnp.einsum('bcjhk,bcjhv->bchkv', k * jnp.exp(b_end[:, :, None] - b), v)

    def step(s_st, inp):
        be, sl = inp
        return jnp.exp(be)[..., None] * s_st + sl, s_st

    s_fin, s_in = lax.scan(step, state, (jnp.moveaxis(b_end, 1, 0), jnp.moveaxis(s_loc, 1, 0)))
    if not need_out:
        return None, s_fin
    s_in = jnp.moveaxis(s_in, 0, 1)
    q_d = q * jnp.exp(b)
    k_d = k * jnp.exp(-b)
    att = jnp.where(_causal_mask(), jnp.einsum('bcthk,bcjhk->bchtj', q_d, k_d), 0.0)
    o = jnp.einsum('bchtj,bcjhv->bcthv', att, v) + jnp.einsum('bcthk,bchkv->bcthv', q_d, s_in)
    return o.reshape(bsz, T, *o.shape[3:]).astype(out_dtype), s_fin


def bidirectional(fn_f, fn_b, ctx_f, lat_f, ctx_b, lat_b, state0, need_ctx_out):
    rev = lambda ts: tuple(jnp.flip(t, axis=1) for t in ts)
    yc_f, s_f = fn_f(*ctx_f, state0, need_ctx_out)
    yl_f, _ = fn_f(*lat_f, s_f, True)
    yc_b, s_b = fn_b(*rev(ctx_b), state0, need_ctx_out)
    yl_b, _ = fn_b(*rev(lat_b), s_b, True)
    y_lat = yl_f + jnp.flip(yl_b, axis=1)
    y_ctx = (yc_f + jnp.flip(yc_b, axis=1)) if need_ctx_out else None
    return y_lat, y_ctx


def ssd_branch(lat, ctx, need_ctx_out, conv_w, conv_b, dt_bias, a_log, d_skip, norm_w, w_br):
    (z, xbc, dt), (zc, xbcc, dtc) = lat, ctx
    xbc, xbcc = short_conv(xbc, xbcc, conv_w, conv_b)

    def prep(t_xbc, t_dt):
        bsz, T = t_xbc.shape[:2]
        xs, bm, cm = _split(jax.nn.silu(t_xbc), (SSD_INNER, SSD_GROUPS * SSD_STATE, SSD_GROUPS * SSD_STATE))
        dts = jax.nn.softplus(t_dt.reshape(bsz, T, 2, SSD_GROUPS, SSD_HPG).astype(jnp.float32)
                              + dt_bias.reshape(2, SSD_GROUPS, SSD_HPG).astype(jnp.float32))
        return (xs.reshape(bsz, T, SSD_GROUPS, SSD_HPG, SSD_HEAD_DIM),
                bm.reshape(bsz, T, SSD_GROUPS, SSD_STATE),
                cm.reshape(bsz, T, SSD_GROUPS, SSD_STATE),
                dts[:, :, 0], dts[:, :, 1])

    xs, bm, cm, dt_f, dt_b = prep(xbc, dt)
    xsc, bmc, cmc, dtc_f, dtc_b = prep(xbcc, dtc)
    a = -jnp.exp(a_log.astype(jnp.float32)).reshape(2, SSD_GROUPS, SSD_HPG)
    state0 = jnp.zeros((xs.shape[0], SSD_GROUPS, SSD_HPG, SSD_HEAD_DIM, SSD_STATE), jnp.float32)
    y, yc = bidirectional(functools.partial(ssd_chunked, a=a[0]), functools.partial(ssd_chunked, a=a[1]),
                          (xsc, dtc_f, bmc, cmc), (xs, dt_f, bm, cm),
                          (xsc, dtc_b, bmc, cmc), (xs, dt_b, bm, cm), state0, need_ctx_out)

    def finish(yy, xx, zz):
        yy = (yy + d_skip.reshape(SSD_GROUPS, SSD_HPG, 1) * xx).reshape(zz.shape)
        return group_norm(yy * jax.nn.silu(zz), norm_w, SSD_GROUPS, False) @ w_br

    return finish(y, xs, z), (finish(yc, xsc, zc) if need_ctx_out else None)


def mlstm_branch(lat, ctx, need_ctx_out, conv_w, conv_b, gate_b, norm_w, w_br):
    (q, k, v, o, g), (qc, kc, vc, oc, gc) = lat, ctx
    qk, qkc = short_conv(jnp.concatenate([q, k], axis=-1), jnp.concatenate([qc, kc], axis=-1), conv_w, conv_b)

    def prep(t_qk, t_v, t_g):
        bsz, T = t_v.shape[:2]
        hq, hk = jnp.split(jax.nn.silu(t_qk), 2, axis=-1)
        hd = (bsz, T, ML_HEADS, ML_HEAD_DIM)
        gates = t_g.reshape(bsz, T, 2, 2, ML_HEADS) + gate_b
        return hq.reshape(hd), hk.reshape(hd), t_v.reshape(hd), gates

    hq, hk, hv, gt = prep(qk, v, g)
    hqc, hkc, hvc, gtc = prep(qkc, vc, gc)
    bsz = hq.shape[0]
    state0 = (jnp.zeros((bsz, ML_HEADS, ML_HEAD_DIM, ML_HEAD_DIM), jnp.float32),
              jnp.zeros((bsz, ML_HEADS, ML_HEAD_DIM), jnp.float32),
              jnp.zeros((bsz, ML_HEADS), jnp.float32))
    y, yc = bidirectional(mlstm_chunked, mlstm_chunked,
                          (hqc, hkc, hvc, gtc[:, :, 0, 0], gtc[:, :, 0, 1]),
                          (hq, hk, hv, gt[:, :, 0, 0], gt[:, :, 0, 1]),
                          (hqc, hkc, hvc, gtc[:, :, 1, 0], gtc[:, :, 1, 1]),
                          (hq, hk, hv, gt[:, :, 1, 0], gt[:, :, 1, 1]), state0, need_ctx_out)

    def finish(hh, oo):
        hh = jax.nn.sigmoid(oo) * hh.reshape(oo.shape)
        return group_norm(hh, norm_w, ML_HEADS, True) @ w_br

    return finish(y, o), (finish(yc, oc) if need_ctx_out else None)


def gla_branch(lat, ctx, need_ctx_out, w2, b2, norm_w, w_br):
    (q, k, v, r, lr), (qc, kc, vc, rc, lrc) = lat, ctx

    def prep(tq, tk, tv, tlr):
        bsz, T = tq.shape[:2]
        kd = (bsz, T, GLA_HEADS, GLA_DK)
        lr2 = tlr.reshape(bsz, T, 2, GLA_RANK)
        log_a = [(jax.nn.log_sigmoid((lr2[:, :, d] @ w2[d] + b2[d]).astype(jnp.float32)) / GLA_TAU).reshape(kd)
                 for d in range(2)]
        return tq.reshape(kd), tk.reshape(kd), tv.reshape(bsz, T, GLA_HEADS, GLA_DV), log_a[0], log_a[1]

    gq, gk, gv, la_f, la_b = prep(q, k, v, lr)
    gqc, gkc, gvc, lac_f, lac_b = prep(qc, kc, vc, lrc)
    state0 = jnp.zeros((gq.shape[0], GLA_HEADS, GLA_DK, GLA_DV), jnp.float32)
    y, yc = bidirectional(gla_chunked, gla_chunked,
                          (gqc, gkc, gvc, lac_f), (gq, gk, gv, la_f),
                          (gqc, gkc, gvc, lac_b), (gq, gk, gv, la_b), state0, need_ctx_out)

    def finish(oo, rr):
        return (group_norm(oo.reshape(rr.shape), norm_w, GLA_HEADS, True) * jax.nn.silu(rr)) @ w_br

    return finish(y, r), (finish(yc, rc) if need_ctx_out else None)


def _merge(b_ssd, b_ml, b_gla, gate_pre, merge_b, w_out):
    g = jax.nn.sigmoid(gate_pre.reshape(*gate_pre.shape[:-1], N_BRANCH, D_MODEL) + merge_b)
    return (g[..., 0, :] * b_ssd + g[..., 1, :] * b_ml + g[..., 2, :] * b_gla) @ w_out


def token_mixer(u, uc, need_ctx_out, w_in, merge_b, ssd_conv_w, ssd_conv_b, ssd_dt_bias, ssd_a_log, ssd_d,
                ssd_norm_w, ml_conv_w, ml_conv_b, ml_gate_b, ml_norm_w, gla_w2, gla_b2, gla_norm_w,
                w_br_ssd, w_br_ml, w_br_gla, w_out):
    pl = _split(u @ w_in, IN_SIZES)
    pc = _split(uc @ w_in, IN_SIZES)
    s_lat, s_ctx = ssd_branch(pl[0:3], pc[0:3], need_ctx_out, ssd_conv_w, ssd_conv_b, ssd_dt_bias,
                              ssd_a_log, ssd_d, ssd_norm_w, w_br_ssd)
    m_lat, m_ctx = mlstm_branch(pl[3:8], pc[3:8], need_ctx_out, ml_conv_w, ml_conv_b, ml_gate_b,
                                ml_norm_w, w_br_ml)
    g_lat, g_ctx = gla_branch(pl[8:13], pc[8:13], need_ctx_out, gla_w2, gla_b2, gla_norm_w, w_br_gla)
    y = _merge(s_lat, m_lat, g_lat, pl[13], merge_b, w_out)
    yc = _merge(s_ctx, m_ctx, g_ctx, pc[13], merge_b, w_out) if need_ctx_out else None
    return y, yc


def _sub_in(h, m, k):
    return h * (1.0 + m[3 * k + 1]) + m[3 * k]


def _sub_out(h, y, m, k, g, b):
    return layer_norm(DEEPNORM_ALPHA * h + m[3 * k + 2] * y, g, b)


def setup_inputs(seed: int = 0) -> dict:
    key = jax.random.key(seed)
    ks = list(jax.random.split(key, 32))

    def nrm(i, shape, scale):
        return jax.random.normal(ks[i], shape, jnp.float32) * scale

    D, L = D_MODEL, DEPTH
    u_dt = jax.random.uniform(ks[30], (L, 2, SSD_HEADS), jnp.float32)
    dt0 = jnp.exp(u_dt * (math.log(0.1) - math.log(0.001)) + math.log(0.001))
    f_bias = jnp.stack([jnp.zeros((ML_HEADS,), jnp.float32), jnp.linspace(3.0, 6.0, ML_HEADS, dtype=jnp.float32)])
    return {
        'x': nrm(0, (BATCH, SEQ, D), 1.0),
        'c': nrm(1, (BATCH, D), 1.0),
        'ctx': nrm(2, (BATCH, CTX_LEN, D), 1.0),
        'c_ctx': nrm(3, (D,), 1.0),
        'w_mod': nrm(4, (L, D, N_MOD * D), 0.5 * D ** -0.5),
        'b_mod': nrm(5, (L, N_MOD * D), 0.02),
        'ln_g': 1.0 + nrm(6, (L, 3, D), 0.02),
        'ln_b': nrm(7, (L, 3, D), 0.02),
        'ffn_w_in': nrm(8, (L, 2, D, 2 * D_FF), D ** -0.5),
        'ffn_w_out': nrm(9, (L, 2, D_FF, D), DEEPNORM_BETA * D_FF ** -0.5),
        'w_in': nrm(10, (L, D, IN_TOTAL), D ** -0.5),
        'merge_b': nrm(11, (L, N_BRANCH, D), 0.02),
        'ssd_conv_w': nrm(12, (L, CONV_K, CONV_K, SSD_XBC), 1.0 / CONV_K),
        'ssd_conv_b': nrm(13, (L, SSD_XBC), 0.02),
        'ssd_dt_bias': dt0 + jnp.log(-jnp.expm1(-dt0)),
        'ssd_a_log': jnp.log(jax.random.uniform(ks[14], (L, 2, SSD_HEADS), jnp.float32, 1.0, 16.0)),
        'ssd_d': 1.0 + nrm(15, (L, SSD_HEADS), 0.1),
        'ssd_norm_w': 1.0 + nrm(16, (L, SSD_INNER), 0.02),
        'ml_conv_w': nrm(17, (L, CONV_K, CONV_K, 2 * ML_WIDTH), 1.0 / CONV_K),
        'ml_conv_b': nrm(18, (L, 2 * ML_WIDTH), 0.02),
        'ml_gate_b': nrm(19, (L, 2, 2, ML_HEADS), 0.1) + f_bias,
        'ml_norm_w': 1.0 + nrm(20, (L, ML_WIDTH), 0.02),
        'gla_w2': nrm(21, (L, 2, GLA_RANK, GLA_KEY_WIDTH), GLA_RANK ** -0.5),
        'gla_b2': nrm(22, (L, 2, GLA_KEY_WIDTH), 0.1),
        'gla_norm_w': 1.0 + nrm(23, (L, GLA_WIDTH), 0.02),
        'w_br_ssd': nrm(24, (L, SSD_INNER, D), DEEPNORM_BETA * SSD_INNER ** -0.5),
        'w_br_ml': nrm(25, (L, ML_WIDTH, D), DEEPNORM_BETA * ML_WIDTH ** -0.5),
        'w_br_gla': nrm(26, (L, GLA_WIDTH, D), DEEPNORM_BETA * GLA_WIDTH ** -0.5),
        'w_out': nrm(27, (L, D, D), DEEPNORM_BETA * D ** -0.5),
    }


def reference(x, c, ctx, c_ctx, w_mod, b_mod, ln_g, ln_b, ffn_w_in, ffn_w_out, w_in, merge_b,
              ssd_conv_w, ssd_conv_b, ssd_dt_bias, ssd_a_log, ssd_d, ssd_norm_w,
              ml_conv_w, ml_conv_b, ml_gate_b, ml_norm_w, gla_w2, gla_b2, gla_norm_w,
              w_br_ssd, w_br_ml, w_br_gla, w_out):
    h, hc = x, ctx
    for l in range(DEPTH):
        need_ctx_out = l < DEPTH - 1
        m_lat = jnp.moveaxis((jax.nn.silu(c) @ w_mod[l] + b_mod[l]).reshape(-1, N_MOD, D_MODEL), 1, 0)[:, :, None, :]
        m_ctx = (jax.nn.silu(c_ctx) @ w_mod[l] + b_mod[l]).reshape(N_MOD, D_MODEL)
        h = _sub_out(h, 0.5 * swiglu(_sub_in(h, m_lat, 0), ffn_w_in[l, 0], ffn_w_out[l, 0]), m_lat, 0, ln_g[l, 0], ln_b[l, 0])
        hc = _sub_out(hc, 0.5 * swiglu(_sub_in(hc, m_ctx, 0), ffn_w_in[l, 0], ffn_w_out[l, 0]), m_ctx, 0, ln_g[l, 0], ln_b[l, 0])
        y, yc = token_mixer(_sub_in(h, m_lat, 1), _sub_in(hc, m_ctx, 1), need_ctx_out, w_in[l], merge_b[l],
                            ssd_conv_w[l], ssd_conv_b[l], ssd_dt_bias[l], ssd_a_log[l], ssd_d[l], ssd_norm_w[l],
                            ml_conv_w[l], ml_conv_b[l], ml_gate_b[l], ml_norm_w[l],
                            gla_w2[l], gla_b2[l], gla_norm_w[l], w_br_ssd[l], w_br_ml[l], w_br_gla[l], w_out[l])
        h = _sub_out(h, y, m_lat, 1, ln_g[l, 1], ln_b[l, 1])
        h = _sub_out(h, 0.5 * swiglu(_sub_in(h, m_lat, 2), ffn_w_in[l, 1], ffn_w_out[l, 1]), m_lat, 2, ln_g[l, 2], ln_b[l, 2])
        if need_ctx_out:
            hc = _sub_out(hc, yc, m_ctx, 1, ln_g[l, 1], ln_b[l, 1])
            hc = _sub_out(hc, 0.5 * swiglu(_sub_in(hc, m_ctx, 2), ffn_w_in[l, 1], ffn_w_out[l, 1]), m_ctx, 2, ln_g[l, 2], ln_b[l, 2])
    return h
```

```cpp
#include <hip/hip_runtime.h>
#include <cstdio>
#include <cstdint>

#ifndef MK_PER_PHASE
#define MK_PER_PHASE 0
#endif
#ifndef PROBE
#define PROBE 0
#endif

namespace pg8 {
#define PG8_LAS __attribute__((address_space(3)))
typedef unsigned short bf16_t;
typedef short bf16x8 __attribute__((ext_vector_type(8)));
typedef float f32x4 __attribute__((ext_vector_type(4)));
typedef unsigned u32x4 __attribute__((ext_vector_type(4)));
constexpr int BM = 256, BK = 64, HALF = 128, HTB = HALF * BK * 2, STAGE_BYTES = 8 * HTB, NXCD = 8, WGM = 8;

__host__ __device__ __forceinline__ int lds_byte(int r, int c) { const int st = (r >> 4) * 2 + (c >> 5), rr = r & 15, cc = c & 31, ob = rr * 64 + cc * 2; return st * 1024 + (ob ^ (((ob >> 9) & 1) << 5)); }
__host__ __device__ __forceinline__ void stage_rc(int b, int& R, int& C) { const int st = b / 1024, sb = b % 1024, swz = sb ^ (((sb >> 9) & 1) << 5); R = (st >> 1) * 16 + swz / 64; C = (st & 1) * 32 + (swz % 64) / 2; }
__host__ __device__ __forceinline__ int perm32(int rho) { const int n = rho >> 4, i = rho & 15; return 8 * (i >> 2) + 4 * n + (i & 3); }

struct Unit { int pm, pn, koff, part; };
struct Gemm { const bf16_t* A; const bf16_t* Bt; int M, N, K, lda, ldb; };

struct StaticOrder {
    int nM, nN, nwg, G, c;
    __host__ __device__ void init(int M, int N, int G_, int c_) { nM = M / BM; nN = N / BM; nwg = nM * nN; G = G_; c = c_; }
    __host__ __device__ bool next(int i, Unit& u) const {
        const long L = (long)i * G + c; if (L >= nwg) return false;
        int wgid = (int)L; { const int q = nwg / NXCD, r = nwg % NXCD, xcd = wgid % NXCD, off = wgid / NXCD; wgid = (xcd < r ? xcd * (q + 1) : r * (q + 1) + (xcd - r) * q) + off; }
        const int nig = WGM * nN, gid = wgid / nig, fm = gid * WGM, gsz = (nM - fm) < WGM ? (nM - fm) : WGM;
        u.pm = fm + ((wgid % nig) % gsz); u.pn = (wgid % nig) / gsz; u.koff = 0; u.part = 0; return true;
    }
    __device__ __forceinline__ void a_ready(const Unit&) const {}
    __device__ __forceinline__ void done(const Unit&) const {}
};
struct PieceOrder {
    int nN, np, KS, kslice_bytes, G, c;
    __host__ __device__ void init(int M, int N, int KS_, int kslice_bytes_, int G_, int c_) { nN = N / BM; np = (M / BM) * nN * KS_; KS = KS_; kslice_bytes = kslice_bytes_; G = G_; c = c_; }
    __host__ __device__ bool next(int i, Unit& u) const { const long L = (long)i * G + c; if (L >= np) return false; const int p = (int)L, t = p / KS, ks = p % KS; u.pm = t / nN; u.pn = t % nN; u.koff = ks * kslice_bytes; u.part = ks; return true; }
    __device__ __forceinline__ void a_ready(const Unit&) const {}
    __device__ __forceinline__ void done(const Unit&) const {}
};

__device__ __forceinline__ unsigned cvt_pk_bf16(float lo, float hi) { unsigned r; asm volatile("v_cvt_pk_bf16_f32 %0, %1, %2" : "=v"(r) : "v"(lo), "v"(hi)); return r; }
__device__ __forceinline__ float bf_lo(unsigned w) { return __uint_as_float(w << 16); }
__device__ __forceinline__ float bf_hi(unsigned w) { return __uint_as_float(w & 0xffff0000u); }
__device__ __forceinline__ float fsigmoid(float x) { return __builtin_amdgcn_rcpf(1.0f + __expf(-x)); }

struct EpiBf16 {
    static constexpr bool PERM = true, AFTER_DRAIN = false;
    bf16_t* O; int ldc;
    __device__ __forceinline__ void operator()(const f32x4 (&acc)[2][2][4][2], const Unit& u, int wr, int wc, int fr, int fq) const {
        const int row0 = u.pm * BM + wr * 64 + fr, col0 = u.pn * BM + wc * 32 + 8 * fq;
#pragma unroll
        for (int ai = 0; ai < 2; ++ai)
#pragma unroll
            for (int m = 0; m < 4; ++m) { bf16_t* rowp = O + (size_t)(row0 + ai * HALF + m * 16) * ldc + col0;
#pragma unroll
                for (int bj = 0; bj < 2; ++bj) { const f32x4 v0 = acc[ai][bj][m][0], v1 = acc[ai][bj][m][1];
                    u32x4 w; w.x = cvt_pk_bf16(v0[0], v0[1]); w.y = cvt_pk_bf16(v0[2], v0[3]); w.z = cvt_pk_bf16(v1[0], v1[1]); w.w = cvt_pk_bf16(v1[2], v1[3]);
                    *(u32x4*)(rowp + bj * HALF) = w; } }
    }
};
struct EpiSwiGLU {
    static constexpr bool PERM = true, AFTER_DRAIN = false;
    bf16_t* O; int ldc;
    __device__ __forceinline__ void operator()(const f32x4 (&acc)[2][2][4][2], const Unit& u, int wr, int wc, int fr, int fq) const {
        const int row0 = u.pm * BM + wr * 64 + fr, col0 = u.pn * HALF + wc * 32 + 8 * fq;
#pragma unroll
        for (int ai = 0; ai < 2; ++ai)
#pragma unroll
            for (int m = 0; m < 4; ++m) { bf16_t* rowp = O + (size_t)(row0 + ai * HALF + m * 16) * ldc + col0;
                float o[8];
#pragma unroll
                for (int n = 0; n < 2; ++n)
#pragma unroll
                    for (int j = 0; j < 4; ++j) { const float a = acc[ai][0][m][n][j], g = acc[ai][1][m][n][j]; o[n * 4 + j] = a * g * fsigmoid(g); }
                u32x4 w; w.x = cvt_pk_bf16(o[0], o[1]); w.y = cvt_pk_bf16(o[2], o[3]); w.z = cvt_pk_bf16(o[4], o[5]); w.w = cvt_pk_bf16(o[6], o[7]);
                *(u32x4*)rowp = w; }
    }
};
struct EpiF32Part {
    static constexpr bool PERM = true, AFTER_DRAIN = false;
    float* C; int ldc; size_t part_stride;
    __device__ __forceinline__ void operator()(const f32x4 (&acc)[2][2][4][2], const Unit& u, int wr, int wc, int fr, int fq) const {
        const int row0 = u.pm * BM + wr * 64 + fr, col0 = u.pn * BM + wc * 32 + 8 * fq; float* base = C + (size_t)u.part * part_stride;
#pragma unroll
        for (int ai = 0; ai < 2; ++ai)
#pragma unroll
            for (int m = 0; m < 4; ++m) { float* rowp = base + (size_t)(row0 + ai * HALF + m * 16) * ldc + col0;
#pragma unroll
                for (int bj = 0; bj < 2; ++bj) { *(f32x4*)(rowp + bj * HALF) = acc[ai][bj][m][0]; *(f32x4*)(rowp + bj * HALF + 4) = acc[ai][bj][m][1]; } }
    }
};
struct EpiNull {
    static constexpr bool PERM = true, AFTER_DRAIN = false;
    int dummy;
    __device__ __forceinline__ void operator()(const f32x4 (&acc)[2][2][4][2], const Unit&, int, int, int, int) const {
#pragma unroll
        for (int ai = 0; ai < 2; ++ai)
#pragma unroll
            for (int m = 0; m < 4; ++m)
#pragma unroll
                for (int bj = 0; bj < 2; ++bj) { asm volatile("" :: "v"(acc[ai][bj][m][0]), "v"(acc[ai][bj][m][1])); }
    }
};
struct EpiInProj {
    static constexpr bool PERM = true, AFTER_DRAIN = false;
    bf16_t* P; int ldp; float* PN; int nwide_tiles;
    __device__ __forceinline__ void operator()(const f32x4 (&acc)[2][2][4][2], const Unit& u, int wr, int wc, int fr, int fq) const {
        const int row0 = u.pm * BM + wr * 64 + fr;
        if (u.pn < nwide_tiles) {
            const int col0 = u.pn * BM + wc * 32 + 8 * fq;
#pragma unroll
            for (int ai = 0; ai < 2; ++ai)
#pragma unroll
                for (int m = 0; m < 4; ++m) { bf16_t* rowp = P + (size_t)(row0 + ai * HALF + m * 16) * ldp + col0;
#pragma unroll
                    for (int bj = 0; bj < 2; ++bj) { const f32x4 v0 = acc[ai][bj][m][0], v1 = acc[ai][bj][m][1];
                        u32x4 w; w.x = cvt_pk_bf16(v0[0], v0[1]); w.y = cvt_pk_bf16(v0[2], v0[3]); w.z = cvt_pk_bf16(v1[0], v1[1]); w.w = cvt_pk_bf16(v1[2], v1[3]);
                        *(u32x4*)(rowp + bj * HALF) = w; } }
        } else {
            const int col0 = wc * 32 + 8 * fq;
#pragma unroll
            for (int ai = 0; ai < 2; ++ai)
#pragma unroll
                for (int m = 0; m < 4; ++m) { float* rowp = PN + (size_t)(row0 + ai * HALF + m * 16) * 256 + col0;
#pragma unroll
                    for (int bj = 0; bj < 2; ++bj) { *(f32x4*)(rowp + bj * HALF) = acc[ai][bj][m][0]; *(f32x4*)(rowp + bj * HALF + 4) = acc[ai][bj][m][1]; } }
        }
    }
};
template <int STAGE> struct EpiBranch {
    static constexpr bool PERM = true, AFTER_DRAIN = false;
    const bf16_t* G; int ldg; const float* mb; float* MACC; bf16_t* MRG; int ldc;
    __device__ __forceinline__ void operator()(const f32x4 (&acc)[2][2][4][2], const Unit& u, int wr, int wc, int fr, int fq) const {
        const int row0 = u.pm * BM + wr * 64 + fr, col0 = u.pn * BM + wc * 32 + 8 * fq;
#pragma unroll
        for (int ai = 0; ai < 2; ++ai)
#pragma unroll
            for (int m = 0; m < 4; ++m) { const size_t row = (size_t)(row0 + ai * HALF + m * 16);
#pragma unroll
                for (int bj = 0; bj < 2; ++bj) { const int col = col0 + bj * HALF;
                    const u32x4 gw = *(const u32x4*)(G + row * ldg + col); const f32x4 b0 = *(const f32x4*)(mb + col), b1 = *(const f32x4*)(mb + col + 4);
                    f32x4 g0, g1;
                    g0[0] = fsigmoid(bf_lo(gw.x) + b0[0]); g0[1] = fsigmoid(bf_hi(gw.x) + b0[1]); g0[2] = fsigmoid(bf_lo(gw.y) + b0[2]); g0[3] = fsigmoid(bf_hi(gw.y) + b0[3]);
                    g1[0] = fsigmoid(bf_lo(gw.z) + b1[0]); g1[1] = fsigmoid(bf_hi(gw.z) + b1[1]); g1[2] = fsigmoid(bf_lo(gw.w) + b1[2]); g1[3] = fsigmoid(bf_hi(gw.w) + b1[3]);
                    f32x4 v0 = g0 * acc[ai][bj][m][0], v1 = g1 * acc[ai][bj][m][1];
                    float* mp = MACC + row * ldc + col;
                    if (STAGE >= 1) { v0 += *(const f32x4*)mp; v1 += *(const f32x4*)(mp + 4); }
                    if (STAGE <= 1) { *(f32x4*)mp = v0; *(f32x4*)(mp + 4) = v1; }
                    else { u32x4 w; w.x = cvt_pk_bf16(v0[0], v0[1]); w.y = cvt_pk_bf16(v0[2], v0[3]); w.z = cvt_pk_bf16(v1[0], v1[1]); w.w = cvt_pk_bf16(v1[2], v1[3]);
                        *(u32x4*)(MRG + row * ldc + col) = w; } } }
    }
};

template <class Epi, class Sched, bool ALIGN_EPI = false, bool SP2 = false>
__device__ __forceinline__ void gemm_phase(PG8_LAS unsigned char* lds, const Gemm g, const Sched& S, const Epi& E) {
    int tid_ = threadIdx.x; asm volatile("" : "+v"(tid_));
    const int tid = tid_, wid = __builtin_amdgcn_readfirstlane(tid >> 6), lane = tid & 63, wr = wid >> 2, wc = wid & 3, fr = lane & 15, fq = lane >> 4;
    const int K = g.K, nt = K / BK;
    unsigned voffA[2], voffB[2];
#pragma unroll
    for (int i = 0; i < 2; ++i) { int R, C; stage_rc(tid * 16 + i * 8192, R, C); const int Rb = Epi::PERM ? ((R & ~31) + perm32(R & 31)) : R;
        voffA[i] = (unsigned)(R * g.lda + C) * 2u; voffB[i] = (unsigned)(Rb * g.ldb + C) * 2u; }
    const size_t kstep = (size_t)(BK * 2);
    const size_t hstepA = (size_t)HALF * g.lda * 2, hstepB = (size_t)HALF * g.ldb * 2;
    const size_t tstepA = 2 * hstepA, tstepB = 2 * hstepB;
    const unsigned ldsw = (unsigned)wid * 1024u;
    const int aoff = lds_byte(wr * 64 + fr, fq * 8), boff = lds_byte(wc * 32 + fr, fq * 8);
#define PG8_SA(b, h) (((b) * 2 + (h)) * HTB)
#define PG8_SB(b, h) ((4 + (b) * 2 + (h)) * HTB)
#define PG8_STAGE(bufoff, gbase, voff) do { _Pragma("unroll") for (int _i = 0; _i < 2; ++_i) \
        __builtin_amdgcn_global_load_lds((const unsigned*)((const char*)(gbase) + (voff)[_i]), (PG8_LAS unsigned*)(lds + (bufoff) + ldsw + _i * 8192), 16, 0, 0); } while (0)
#define PG8_LDA(dst, b, h) do { _Pragma("unroll") for (int m = 0; m < 4; ++m) _Pragma("unroll") for (int k = 0; k < 2; ++k) dst[m][k] = *(const PG8_LAS bf16x8*)(lds + PG8_SA(b, h) + aoff + m * 2048 + k * 1024); } while (0)
#define PG8_LDB(dst, b, h) do { _Pragma("unroll") for (int n = 0; n < 2; ++n) _Pragma("unroll") for (int k = 0; k < 2; ++k) dst[n][k] = *(const PG8_LAS bf16x8*)(lds + PG8_SB(b, h) + boff + n * 2048 + k * 1024); } while (0)
#define PG8_MMA(ai, bj, At, Bt) do { __builtin_amdgcn_s_setprio(1); _Pragma("unroll") for (int m = 0; m < 4; ++m) _Pragma("unroll") for (int n = 0; n < 2; ++n) _Pragma("unroll") for (int k = 0; k < 2; ++k) \
        acc[ai][bj][m][n] = __builtin_amdgcn_mfma_f32_16x16x32_bf16(Bt[n][k], At[m][k], acc[ai][bj][m][n], 0, 0, 0); __builtin_amdgcn_s_setprio(0); } while (0)
#define PG8_WAIT_V(n) asm volatile("s_waitcnt vmcnt(" #n ")" ::: "memory")
#define PG8_WAIT_L(n) asm volatile("s_waitcnt lgkmcnt(" #n ")" ::: "memory")
#define PG8_BAR __builtin_amdgcn_s_barrier()
#define PG8_SCHED __builtin_amdgcn_sched_barrier(0)
    Unit cur, nxt; int ui = 0;
    if (!S.next(0, cur)) return;
    f32x4 acc[2][2][4][2];
#pragma unroll
    for (int a = 0; a < 2; ++a)
#pragma unroll
        for (int b = 0; b < 2; ++b)
#pragma unroll
            for (int m = 0; m < 4; ++m)
#pragma unroll
                for (int n = 0; n < 2; ++n) acc[a][b][m][n] = (f32x4){0.f, 0.f, 0.f, 0.f};
    bf16x8 At[4][2], B0[2][2], B1[2][2];
    const char* cA = (const char*)g.A + (size_t)cur.pm * tstepA + cur.koff; const char* cB = (const char*)g.Bt + (size_t)cur.pn * tstepB + cur.koff;
    S.a_ready(cur);
    if constexpr (SP2) {
        PG8_STAGE(PG8_SB(0, 0), cB, voffB); PG8_STAGE(PG8_SB(0, 1), cB + hstepB, voffB); PG8_STAGE(PG8_SA(0, 0), cA, voffA); PG8_STAGE(PG8_SA(0, 1), cA + hstepA, voffA);
        if (wr == 1) PG8_BAR;
        PG8_WAIT_V(2); PG8_BAR;
        PG8_STAGE(PG8_SB(1, 0), cB + kstep, voffB); PG8_STAGE(PG8_SA(1, 0), cA + kstep, voffA); PG8_STAGE(PG8_SB(1, 1), cB + hstepB + kstep, voffB);
        PG8_WAIT_V(6); PG8_BAR;
    } else {
        PG8_STAGE(PG8_SB(0, 0), cB, voffB); PG8_STAGE(PG8_SA(0, 0), cA, voffA); PG8_STAGE(PG8_SB(0, 1), cB + hstepB, voffB); PG8_STAGE(PG8_SA(0, 1), cA + hstepA, voffA);
        if (wr == 1) PG8_BAR;
        PG8_WAIT_V(4); PG8_BAR;
        PG8_STAGE(PG8_SB(1, 0), cB + kstep, voffB); PG8_STAGE(PG8_SA(1, 0), cA + kstep, voffA); PG8_STAGE(PG8_SB(1, 1), cB + hstepB + kstep, voffB);
        PG8_WAIT_V(6); PG8_BAR;
    }
    for (;;) {
        const bool has_next = S.next(ui + 1, nxt);
        const char* nA = has_next ? (const char*)g.A + (size_t)nxt.pm * tstepA + nxt.koff : cA; const char* nB = has_next ? (const char*)g.Bt + (size_t)nxt.pn * tstepB + nxt.koff : cB;
        for (int t = 0; t < nt; t += 2) {
            const bool last = (t == nt - 2);
            const char* a1 = cA + (size_t)(t + 1) * kstep;
            const char* a2 = last ? nA : cA + (size_t)(t + 2) * kstep; const char* b2 = last ? nB : cB + (size_t)(t + 2) * kstep;
            const char* a3 = a2 + kstep; const char* b3 = b2 + kstep;
            if (last && has_next) S.a_ready(nxt);
            if constexpr (SP2) {
            PG8_LDB(B0, 0, 0); PG8_LDB(B1, 0, 1); PG8_SCHED; PG8_LDA(At, 0, 0); PG8_STAGE(PG8_SA(1, 1), a1 + hstepA, voffA);
            PG8_WAIT_V(8); PG8_WAIT_L(0); PG8_BAR; PG8_MMA(0, 0, At, B0); PG8_MMA(0, 1, At, B1); PG8_BAR; PG8_SCHED;
            PG8_LDA(At, 0, 1); PG8_STAGE(PG8_SB(0, 0), b2, voffB); PG8_STAGE(PG8_SB(0, 1), b2 + hstepB, voffB); PG8_STAGE(PG8_SA(0, 0), a2, voffA);
            PG8_WAIT_V(8); PG8_WAIT_L(0); PG8_BAR; PG8_MMA(1, 0, At, B0); PG8_MMA(1, 1, At, B1); PG8_BAR; PG8_SCHED;
            PG8_LDB(B0, 1, 0); PG8_LDB(B1, 1, 1); PG8_SCHED; PG8_LDA(At, 1, 0); PG8_STAGE(PG8_SA(0, 1), a2 + hstepA, voffA);
            PG8_WAIT_V(8); PG8_WAIT_L(0); PG8_BAR; PG8_MMA(0, 0, At, B0); PG8_MMA(0, 1, At, B1); PG8_BAR; PG8_SCHED;
            PG8_LDA(At, 1, 1); PG8_STAGE(PG8_SB(1, 0), b3, voffB); PG8_STAGE(PG8_SB(1, 1), b3 + hstepB, voffB); PG8_STAGE(PG8_SA(1, 0), a3, voffA);
            PG8_WAIT_V(8); PG8_WAIT_L(0); PG8_BAR; PG8_MMA(1, 0, At, B0); PG8_MMA(1, 1, At, B1); PG8_BAR; PG8_SCHED;
            } else {
            PG8_LDB(B0, 0, 0); PG8_SCHED; PG8_LDA(At, 0, 0); PG8_STAGE(PG8_SA(1, 1), a1 + hstepA, voffA);
            PG8_WAIT_L(8); PG8_BAR; PG8_WAIT_L(0); PG8_MMA(0, 0, At, B0); PG8_BAR; PG8_SCHED;
            PG8_LDB(B1, 0, 1); PG8_STAGE(PG8_SB(0, 0), b2, voffB);
            PG8_BAR; PG8_WAIT_L(0); PG8_MMA(0, 1, At, B1); PG8_BAR;
            PG8_LDA(At, 0, 1); PG8_STAGE(PG8_SA(0, 0), a2, voffA);
            PG8_BAR; PG8_WAIT_L(0); PG8_MMA(1, 0, At, B0); PG8_BAR; PG8_SCHED;
            PG8_STAGE(PG8_SB(0, 1), b2 + hstepB, voffB);
            PG8_WAIT_V(6); PG8_BAR; PG8_MMA(1, 1, At, B1); PG8_BAR;
            PG8_LDB(B0, 1, 0); PG8_SCHED; PG8_LDA(At, 1, 0); PG8_STAGE(PG8_SA(0, 1), a2 + hstepA, voffA);
            PG8_WAIT_L(8); PG8_BAR; PG8_WAIT_L(0); PG8_MMA(0, 0, At, B0); PG8_BAR; PG8_SCHED;
            PG8_LDB(B1, 1, 1); PG8_STAGE(PG8_SB(1, 0), b3, voffB);
            PG8_BAR; PG8_WAIT_L(0); PG8_MMA(0, 1, At, B1); PG8_BAR;
            PG8_LDA(At, 1, 1); PG8_STAGE(PG8_SA(1, 0), a3, voffA);
            PG8_BAR; PG8_WAIT_L(0); PG8_MMA(1, 0, At, B0); PG8_BAR; PG8_SCHED;
            PG8_STAGE(PG8_SB(1, 1), b3 + hstepB, voffB);
            PG8_WAIT_V(6); PG8_BAR; PG8_MMA(1, 1, At, B1); PG8_BAR;
            }
        }
        if constexpr (ALIGN_EPI) { if (wr == 0) PG8_BAR; }
        if constexpr (!Epi::AFTER_DRAIN) { E(acc, cur, wr, wc, fr, fq); S.done(cur); }
        if (!has_next) break;
#pragma unroll
        for (int a = 0; a < 2; ++a)
#pragma unroll
            for (int b = 0; b < 2; ++b)
#pragma unroll
                for (int m = 0; m < 4; ++m)
#pragma unroll
                    for (int n = 0; n < 2; ++n) acc[a][b][m][n] = (f32x4){0.f, 0.f, 0.f, 0.f};
        cur = nxt; cA = nA; cB = nB; ++ui;
        if constexpr (ALIGN_EPI) { if (wr == 1) PG8_BAR; }
    }
    PG8_WAIT_V(0);
    if constexpr (!ALIGN_EPI) { if (wr == 0) PG8_BAR; }
    PG8_BAR;
#undef PG8_SA
#undef PG8_SB
#undef PG8_STAGE
#undef PG8_LDA
#undef PG8_LDB
#undef PG8_MMA
#undef PG8_WAIT_V
#undef PG8_WAIT_L
#undef PG8_BAR
#undef PG8_SCHED
}
}

#define PG8_SP2 true
#define PG8_ALIGN true

constexpr int NWAVES = 8;
constexpr int D = 2048, NB = 4, SEQ = 4096, CTXL = 256, DEPTH = 2;
constexpr int ML = NB * SEQ, MC = NB * CTXL, M = ML + MC;
constexpr int DFF = 5632, NFF = 2 * DFF, NMOD = 9 * D;
constexpr int NSRC = 12368, NWIDE = 12288, NIN = 12544;
constexpr int CVW = 2560;
constexpr float EPS = 1e-5f, ALPHA = 1.4142135623730951f;
constexpr int PC_Z = 0, PC_XBC = 1024, PC_MQ = 2560, PC_MV = 3584, PC_MO = 4096, PC_GQ = 4608, PC_GK = 4864, PC_GV = 5120, PC_GR = 5632, PC_GATE = 6144;

constexpr size_t MiB = 1u << 20;
constexpr size_t WS_CTL = 0, CTL_ZERO_BYTES = 1 * MiB;
constexpr size_t WS_MOD = 1 * MiB;
constexpr size_t WS_WB = 2 * MiB;
constexpr size_t WB_FIN = 0, WB_FOUT = WB_FIN + 2 * (size_t)NFF * D * 2, WB_WIN = WB_FOUT + 2 * (size_t)D * DFF * 2, WB_BRS = WB_WIN + (size_t)NIN * D * 2,
                 WB_BRM = WB_BRS + (size_t)D * 1024 * 2, WB_BRG = WB_BRM + (size_t)D * 512 * 2, WB_OUT = WB_BRG + (size_t)D * 512 * 2, WB_END = WB_OUT + (size_t)D * D * 2;
static_assert(WB_END <= 200 * MiB, "weights region");
constexpr size_t WS_H = 202 * MiB;
constexpr size_t WS_U = 338 * MiB;
constexpr size_t WS_Y = 406 * MiB;
constexpr size_t WS_BIG = 474 * MiB;
constexpr size_t WS_PN = 882 * MiB;
constexpr size_t WS_CV = 899 * MiB;
constexpr size_t WS_DT = 984 * MiB;
constexpr size_t WS_DA = WS_DT + (size_t)M * 32 * 4;
constexpr size_t WS_MLG = 989 * MiB;
constexpr size_t WS_DEN = WS_MLG + (size_t)M * 16 * 4;
constexpr size_t WS_GD = 991 * MiB;
constexpr size_t WS_YS = 1025 * MiB;
constexpr size_t WS_YP = 1297 * MiB;
constexpr size_t WS_END = 1329 * MiB;
static_assert(WS_H + (size_t)M * D * 4 <= WS_U && WS_U + (size_t)M * D * 2 <= WS_Y && WS_Y + (size_t)M * D * 2 <= WS_BIG && WS_BIG + (size_t)M * NWIDE * 2 <= WS_PN &&
              WS_PN + (size_t)M * 256 * 4 <= WS_CV && WS_CV + (size_t)M * CVW * 2 <= WS_DT && WS_DA + (size_t)M * 32 * 4 <= WS_MLG && WS_DEN + 2 * (size_t)M * 4 * 4 <= WS_GD &&
              WS_GD + (size_t)M * 512 * 4 <= WS_YS && WS_YS + 2 * (size_t)M * D * 4 <= WS_YP && WS_YP + 4 * (size_t)MC * D * 4 <= WS_END, "d_ws map");
constexpr int CW_BAR = 4096;

constexpr int RING_OFF = 0, RING_BYTES = 131072;
constexpr int LDSCTL_OFF = RING_BYTES, MISC_OFF = LDSCTL_OFF + 320;
constexpr int LDS_BYTES = 147456;

#define GAS __attribute__((address_space(1)))
#define LAS __attribute__((address_space(3)))
typedef unsigned short bf16;
typedef unsigned v4u __attribute__((ext_vector_type(4)));
typedef unsigned v2u __attribute__((ext_vector_type(2)));
typedef float f32x4 __attribute__((ext_vector_type(4)));
#define LDS_WAIT() asm volatile("s_waitcnt lgkmcnt(0)" ::: "memory")
#define VM_WAIT() asm volatile("s_waitcnt vmcnt(0)" ::: "memory")
__device__ __forceinline__ unsigned f2bf(float f) { unsigned u = __builtin_bit_cast(unsigned, f); return (u + 0x7fffu + ((u >> 16) & 1u)) >> 16; }
__device__ __forceinline__ unsigned pk2(float lo, float hi) { unsigned r; asm("v_cvt_pk_bf16_f32 %0, %1, %2" : "=v"(r) : "v"(lo), "v"(hi)); return r; }
__device__ __forceinline__ float bflo(unsigned w) { return __uint_as_float(w << 16); }
__device__ __forceinline__ float bfhi(unsigned w) { return __uint_as_float(w & 0xffff0000u); }
__device__ __forceinline__ float silu_f(float x) { return x / (1.0f + __expf(-x)); }
__device__ __forceinline__ float sigm_f(float x) { return 1.0f / (1.0f + __expf(-x)); }
__device__ __forceinline__ float softplus_f(float x) { return fmaxf(x, 0.f) + log1pf(__expf(-fabsf(x))); }

#define XB_TMO      128
#define XB_XCNT(j)  (256  + 64 * (j))
#define XB_XSUB(j)  (1280 + 64 * (j))
#define XB_XGEN(j)  (2304 + 64 * (j))
#define XB_TOP      3328
#define XB_TOPGEN   3392
#define XCD_BAR_WORDS 3456
#define XB_SPIN_CAP (1u << 18)
__device__ __forceinline__ unsigned xb_ld(unsigned* p)              { return __hip_atomic_load(p, __ATOMIC_RELAXED, __HIP_MEMORY_SCOPE_AGENT); }
__device__ __forceinline__ unsigned xb_add(unsigned* p, unsigned v) { return __hip_atomic_fetch_add(p, v, __ATOMIC_RELAXED, __HIP_MEMORY_SCOPE_AGENT); }
__device__ __forceinline__ unsigned xb_xcc_id() { return (unsigned)__builtin_amdgcn_s_getreg((3 << 11) | 20) & 0xFu; }
#define XB_SPIN(cond, bar) do { unsigned _sp = 0; while (cond) { __builtin_amdgcn_s_sleep(1); \
    if ((++_sp & 255u) == 0u) { if (xb_ld(&(bar)[XB_TMO])) break; if (_sp > XB_SPIN_CAP) { atomicAdd(&(bar)[XB_TMO], 1u); break; } } } } while (0)
struct XcdBarrier { unsigned* bar; unsigned x; volatile LAS unsigned* st; };
__device__ __forceinline__ XcdBarrier xcd_barrier_post(unsigned* bar, volatile LAS unsigned* st) {
    XcdBarrier b; b.bar = bar; b.x = xb_xcc_id(); b.st = st;
    if (threadIdx.x == 0) (void)xb_add(&bar[XB_XCNT(b.x)], 1u);
    return b;
}
__device__ __forceinline__ void xcd_barrier_complete(unsigned* bar, unsigned x, unsigned& nloc, unsigned& nx) {
    const unsigned G = gridDim.x * gridDim.y * gridDim.z;
    unsigned sum, cnt, mine, sp = 0u;
    for (;;) {
        sum = 0u; cnt = 0u; mine = 0u;
#pragma unroll
        for (unsigned j = 0; j < 16; ++j) { const unsigned c = xb_ld(&bar[XB_XCNT(j)]); sum += c; cnt += (c > 0u) ? 1u : 0u; mine = (j == x) ? c : mine; }
        if (sum == G) break;
        __builtin_amdgcn_s_sleep(1);
        if ((++sp & 255u) == 0u) { if (xb_ld(&bar[XB_TMO])) break; if (sp > XB_SPIN_CAP) { atomicAdd(&bar[XB_TMO], 1u); break; } }
    }
    nloc = mine > 0u ? mine : 1u; nx = cnt > 0u ? cnt : 1u;
}
__device__ __forceinline__ void xcd_barrier(const XcdBarrier& b) {
    asm volatile("s_waitcnt vmcnt(0)" ::: "memory");
    __syncthreads();
    if (threadIdx.x == 0) {
        unsigned* bar = b.bar; asm volatile("" : "+s"(bar));
        __builtin_amdgcn_s_waitcnt(0);
        unsigned nloc = b.st[0], nx = b.st[1];
        if (nloc == 0u) { xcd_barrier_complete(bar, b.x, nloc, nx); b.st[0] = nloc; b.st[1] = nx; }
        const unsigned old = xb_add(&bar[XB_XSUB(b.x)], 1u);
        const unsigned gen = old / nloc;
        if (old + 1u == (gen + 1u) * nloc) {
            __builtin_amdgcn_fence(__ATOMIC_RELEASE, "agent");
            asm volatile("s_waitcnt vmcnt(0)" ::: "memory");
            const unsigned og = xb_add(&bar[XB_TOP], 1u);
            const unsigned tg = og / nx;
            if (og + 1u == (tg + 1u) * nx) xb_add(&bar[XB_TOPGEN], 1u);
            else XB_SPIN(xb_ld(&bar[XB_TOPGEN]) == tg, bar);
            __builtin_amdgcn_fence(__ATOMIC_ACQUIRE, "agent");
            xb_add(&bar[XB_XGEN(b.x)], 1u);
            asm volatile("s_waitcnt vmcnt(0)" ::: "memory");
        } else {
            XB_SPIN(xb_ld(&bar[XB_XGEN(b.x)]) == gen, bar);
            __builtin_amdgcn_fence(__ATOMIC_ACQUIRE, "agent");
            asm volatile("s_waitcnt vmcnt(0)" ::: "memory");
        }
    }
    __syncthreads();
}

struct Args { const float* in[29]; float* out; unsigned char* ws; int ph_lo, ph_hi; };
enum { I_X = 0, I_C, I_CTX, I_CCTX, I_WMOD, I_BMOD, I_LNG, I_LNB, I_FWIN, I_FWOUT, I_WIN, I_MERGEB, I_SCW, I_SCB, I_SDTB, I_SALOG, I_SD, I_SNW,
       I_MCW, I_MCB, I_MGB, I_MNW, I_GW2, I_GB2, I_GNW, I_WBS, I_WBM, I_WBG, I_WOUT };
#define CAS __attribute__((address_space(4)))
struct Frame {
    LAS unsigned char* lds;
    int tid, lane, wave, G, gw, NGW;
    const float* const CAS* in; float* out; unsigned char* ws;
};
__device__ __forceinline__ Frame mkframe(LAS unsigned char* lds) {
    Frame F; F.lds = lds;
    int t = threadIdx.x; asm volatile("" : "+v"(t));
    F.tid = t; F.lane = t & 63; F.wave = __builtin_amdgcn_readfirstlane(t >> 6);
    F.G = gridDim.x; F.gw = blockIdx.x * NWAVES + F.wave; F.NGW = F.G * NWAVES;
    const CAS Args* a = (const CAS Args*)__builtin_amdgcn_kernarg_segment_ptr(); asm volatile("" : "+s"(a));
    F.in = a->in; F.out = a->out; F.ws = a->ws;
    return F;
}
__device__ __forceinline__ float wave_sum(float v) {
#pragma unroll
    for (int o = 1; o < 64; o <<= 1) v += __shfl_xor(v, o);
    return v;
}
__device__ __forceinline__ float half_sum(float v) {
#pragma unroll
    for (int o = 1; o < 32; o <<= 1) v += __shfl_xor(v, o);
    return v;
}

__device__ __forceinline__ void tr_item(const float* W, int ldw, int k0, int c0, int ncols, bf16* WT, int ldt, int r0, LAS float* scr, int lane) {
    const int n4 = 4 * (lane & 7);
    f32x4 v[8];
#pragma unroll
    for (int i = 0; i < 8; ++i) { const int kk = 8 * i + (lane >> 3); v[i] = (n4 < ncols) ? *(const GAS f32x4*)(W + (size_t)(k0 + kk) * ldw + c0 + n4) : (f32x4){0.f, 0.f, 0.f, 0.f}; }
#pragma unroll
    for (int i = 0; i < 8; ++i) { const int kk = 8 * i + (lane >> 3); LAS float* d = scr + kk * 33 + n4; d[0] = v[i][0]; d[1] = v[i][1]; d[2] = v[i][2]; d[3] = v[i][3]; }
    LDS_WAIT(); asm volatile("" ::: "memory");
    const int c = lane & 7;
#pragma unroll
    for (int j = 0; j < 4; ++j) { const int n = (lane >> 3) + 8 * j; const LAS float* s = scr + (8 * c) * 33 + n;
        v4u o; o.x = pk2(s[0 * 33], s[1 * 33]); o.y = pk2(s[2 * 33], s[3 * 33]); o.z = pk2(s[4 * 33], s[5 * 33]); o.w = pk2(s[6 * 33], s[7 * 33]);
        *(GAS v4u*)(WT + (size_t)(r0 + n) * ldt + k0 + 8 * c) = o; }
    LDS_WAIT(); asm volatile("" ::: "memory");
}
__device__ __forceinline__ void convert_weights(Frame& F, int l) {
    LAS float* scr = (LAS float*)(F.lds + RING_OFF + F.wave * 16384);
    unsigned char* wb = F.ws + WS_WB;
    constexpr int I_FI = (D / 64) * (NFF / 32), I_FO = (DFF / 64) * (D / 32), I_IN = (D / 64) * (NIN / 32), I_BS = (1024 / 64) * (D / 32), I_BM = (512 / 64) * (D / 32), I_O = (D / 64) * (D / 32);
    constexpr int NITEMS = 2 * I_FI + 2 * I_FO + I_IN + I_BS + 2 * I_BM + I_O;
    for (int it = F.gw; it < NITEMS; it += F.NGW) {
        int r = it;
        if (r < 2 * I_FI) { const int f = r / I_FI; r -= f * I_FI; const int kb = r / (NFF / 32), nb = r % (NFF / 32), c0 = 32 * nb;
            const int r0 = c0 < DFF ? 256 * (c0 / 128) + (c0 % 128) : 256 * ((c0 - DFF) / 128) + 128 + ((c0 - DFF) % 128);
            tr_item(F.in[I_FWIN] + (size_t)(l * 2 + f) * D * NFF, NFF, 64 * kb, c0, 32, (bf16*)(wb + WB_FIN) + (size_t)f * NFF * D, D, r0, scr, F.lane); continue; }
        r -= 2 * I_FI;
        if (r < 2 * I_FO) { const int f = r / I_FO; r -= f * I_FO; const int kb = r / (D / 32), nb = r % (D / 32);
            tr_item(F.in[I_FWOUT] + (size_t)(l * 2 + f) * DFF * D, D, 64 * kb, 32 * nb, 32, (bf16*)(wb + WB_FOUT) + (size_t)f * D * DFF, DFF, 32 * nb, scr, F.lane); continue; }
        r -= 2 * I_FO;
        if (r < I_IN) { const int kb = r / (NIN / 32), db = r % (NIN / 32), r0 = 32 * db; int c0 = 0, nc = 32;
            if (r0 < 2560) c0 = r0; else if (r0 < 4608) c0 = r0 - 2560 + 2592; else if (r0 < 6144) c0 = r0 - 4608 + 4656; else if (r0 < NWIDE) c0 = r0 - 6144 + 6224;
            else if (r0 == NWIDE) c0 = 2560; else if (r0 == NWIDE + 32) c0 = 6192; else if (r0 == NWIDE + 64) { c0 = 4640; nc = 16; } else nc = 0;
            tr_item(F.in[I_WIN] + (size_t)l * D * NSRC, NSRC, 64 * kb, c0, nc, (bf16*)(wb + WB_WIN), D, r0, scr, F.lane); continue; }
        r -= I_IN;
        if (r < I_BS) { const int kb = r / (D / 32), nb = r % (D / 32); tr_item(F.in[I_WBS] + (size_t)l * 1024 * D, D, 64 * kb, 32 * nb, 32, (bf16*)(wb + WB_BRS), 1024, 32 * nb, scr, F.lane); continue; }
        r -= I_BS;
        if (r < I_BM) { const int kb = r / (D / 32), nb = r % (D / 32); tr_item(F.in[I_WBM] + (size_t)l * 512 * D, D, 64 * kb, 32 * nb, 32, (bf16*)(wb + WB_BRM), 512, 32 * nb, scr, F.lane); continue; }
        r -= I_BM;
        if (r < I_BM) { const int kb = r / (D / 32), nb = r % (D / 32); tr_item(F.in[I_WBG] + (size_t)l * 512 * D, D, 64 * kb, 32 * nb, 32, (bf16*)(wb + WB_BRG), 512, 32 * nb, scr, F.lane); continue; }
        r -= I_BM;
        { const int kb = r / (D / 32), nb = r % (D / 32); tr_item(F.in[I_WOUT] + (size_t)l * D * D, D, 64 * kb, 32 * nb, 32, (bf16*)(wb + WB_OUT), D, 32 * nb, scr, F.lane); }
    }
}
__device__ __forceinline__ void mod_phase(Frame& F) {
    LAS float* ss = (LAS float*)(F.lds + RING_OFF);
    LAS float* red = (LAS float*)(F.lds + RING_OFF + 40960);
    float* MOD = (float*)(F.ws + WS_MOD);
    __syncthreads();
    for (int i = F.tid; i < 5 * D; i += NWAVES * 64) { const int b = i / D, k = i % D; const float v = b < NB ? F.in[I_C][b * D + k] : F.in[I_CCTX][k]; ss[i] = silu_f(v); }
    __syncthreads();
    const int half = F.lane >> 5, cl = F.lane & 31;
    for (int unit = blockIdx.x; unit < 2 * (NMOD / 128); unit += F.G) {
        const int l = unit / (NMOD / 128), col0 = (unit % (NMOD / 128)) * 128;
        const float* wp = F.in[I_WMOD] + (size_t)l * D * NMOD + col0 + 4 * cl;
        f32x4 a0 = {0.f, 0.f, 0.f, 0.f}, a1 = a0, a2 = a0, a3 = a0, a4 = a0;
#pragma unroll 8
        for (int i = 0; i < 128; ++i) { const int k = 256 * F.wave + 2 * i + half; const f32x4 wv = *(const GAS f32x4*)(wp + (size_t)k * NMOD);
            a0 += ss[k] * wv; a1 += ss[D + k] * wv; a2 += ss[2 * D + k] * wv; a3 += ss[3 * D + k] * wv; a4 += ss[4 * D + k] * wv; }
#pragma unroll
        for (int j = 0; j < 4; ++j) { a0[j] += __shfl_xor(a0[j], 32); a1[j] += __shfl_xor(a1[j], 32); a2[j] += __shfl_xor(a2[j], 32); a3[j] += __shfl_xor(a3[j], 32); a4[j] += __shfl_xor(a4[j], 32); }
        if (F.lane < 32) { LAS f32x4* rp = (LAS f32x4*)(red + F.wave * 640) + cl; rp[0] = a0; rp[32] = a1; rp[64] = a2; rp[96] = a3; rp[128] = a4; }
        __syncthreads();
        for (int o = F.tid; o < 640; o += NWAVES * 64) { const int b = o / 128, cc = o % 128; float s = F.in[I_BMOD][l * NMOD + col0 + cc];
#pragma unroll
            for (int w = 0; w < 8; ++w) s += red[w * 640 + o];
            MOD[(size_t)(l * 5 + b) * NMOD + col0 + cc] = s; }
        __syncthreads();
    }
}
__device__ __forceinline__ void modulate_rows(Frame& F, int l, int k, int rows) {
    const float* MOD = (const float*)(F.ws + WS_MOD); bf16* U = (bf16*)(F.ws + WS_U);
    for (int rr = F.gw; rr < rows; rr += 2 * F.NGW) {
        f32x4 u[2][8];
#pragma unroll
        for (int q = 0; q < 2; ++q) { const int r0 = rr + q * F.NGW, r = r0 < rows ? r0 : rr; const int b = r < ML ? r / SEQ : NB;
            const float* hp = r < ML ? F.in[I_X] + (size_t)r * D : F.in[I_CTX] + (size_t)(r - ML) * D;
            const float* mA = MOD + (size_t)(l * 5 + b) * NMOD + (3 * k + 1) * D; const float* mB = MOD + (size_t)(l * 5 + b) * NMOD + (3 * k) * D;
#pragma unroll
            for (int j = 0; j < 8; ++j) { const int c = 4 * F.lane + 256 * j; const f32x4 h = *(const GAS f32x4*)(hp + c), a = *(const GAS f32x4*)(mA + c), bb = *(const GAS f32x4*)(mB + c); u[q][j] = h * (1.0f + a) + bb; } }
#pragma unroll
        for (int q = 0; q < 2; ++q) { const int r = rr + q * F.NGW; if (r >= rows) continue;
#pragma unroll
            for (int j = 0; j < 8; ++j) { const int c = 4 * F.lane + 256 * j; v2u w; w.x = pk2(u[q][j][0], u[q][j][1]); w.y = pk2(u[q][j][2], u[q][j][3]); *(GAS v2u*)(U + (size_t)r * D + c) = w; } }
    }
}
struct LnArgs { int l, k, ln_idx, lnx, kn; float gate_scale; bool hin_input, write_u, final_out, dummy; };
template <int NR, bool PARTS> __device__ __forceinline__ void ln_span(Frame& F, const LnArgs a, int rlo, int rhi) {
    const float* YP = (const float*)(F.ws + WS_YP);
    const float* MOD = (const float*)(F.ws + WS_MOD); bf16* U = (bf16*)(F.ws + (a.dummy ? WS_YS + 136 * MiB : WS_U)); const bf16* Y = (const bf16*)(F.ws + WS_Y); const float* H = (const float*)(F.ws + WS_H); float* HO = (float*)(F.ws + (a.dummy ? WS_YS : WS_H));
    const float* lg = F.in[I_LNG] + (size_t)(a.l * 3 + a.ln_idx) * D; const float* lb = F.in[I_LNB] + (size_t)(a.l * 3 + a.ln_idx) * D;
    for (int rr = rlo + F.gw; rr < rhi; rr += NR * F.NGW) {
        f32x4 t[NR][8]; float s[NR]; int rw[NR], bw[NR];
#pragma unroll
        for (int q = 0; q < NR; ++q) { s[q] = 0.f; const int r = rr + q * F.NGW; rw[q] = r; const int rc = r < rhi ? r : rr; const int b = rc < ML ? rc / SEQ : NB; bw[q] = b;
            const float* hp = a.hin_input ? (rc < ML ? F.in[I_X] + (size_t)rc * D : F.in[I_CTX] + (size_t)(rc - ML) * D) : H + (size_t)rc * D;
            const float* mg = MOD + (size_t)(a.l * 5 + b) * NMOD + (3 * a.k + 2) * D;
#pragma unroll
            for (int j = 0; j < 8; ++j) { const int c = 4 * F.lane + 256 * j; const f32x4 h = *(const GAS f32x4*)(hp + c), g = *(const GAS f32x4*)(mg + c);
                f32x4 y;
                if (PARTS) { const float* yp = YP + (size_t)(rc - ML) * D + c; y = (*(const GAS f32x4*)yp + *(const GAS f32x4*)(yp + (size_t)MC * D)) + (*(const GAS f32x4*)(yp + 2 * (size_t)MC * D) + *(const GAS f32x4*)(yp + 3 * (size_t)MC * D)); }
                else { const v2u yw = *(const GAS v2u*)(Y + (size_t)rc * D + c); y[0] = bflo(yw.x); y[1] = bfhi(yw.x); y[2] = bflo(yw.y); y[3] = bfhi(yw.y); }
                t[q][j] = ALPHA * h + (a.gate_scale * g) * y; s[q] += (t[q][j][0] + t[q][j][1]) + (t[q][j][2] + t[q][j][3]); } }
#pragma unroll
        for (int q = 0; q < NR; ++q) { const int r = rw[q]; if (r >= rhi) continue; const int b = bw[q];
            const float mean = wave_sum(s[q]) * (1.f / D); float s2 = 0.f;
#pragma unroll
            for (int j = 0; j < 8; ++j) { t[q][j] = t[q][j] - mean; s2 += (t[q][j][0] * t[q][j][0] + t[q][j][1] * t[q][j][1]) + (t[q][j][2] * t[q][j][2] + t[q][j][3] * t[q][j][3]); }
            const float rstd = 1.f / sqrtf(wave_sum(s2) * (1.f / D) + EPS);
            const float* mA = MOD + (size_t)(a.lnx * 5 + b) * NMOD + (3 * a.kn + 1) * D; const float* mB = MOD + (size_t)(a.lnx * 5 + b) * NMOD + (3 * a.kn) * D;
#pragma unroll
            for (int j = 0; j < 8; ++j) { const int c = 4 * F.lane + 256 * j; const f32x4 g = *(const GAS f32x4*)(lg + c), be = *(const GAS f32x4*)(lb + c);
                const f32x4 o = t[q][j] * rstd * g + be;
                if (a.final_out && !a.dummy) { if (r < ML) *(GAS f32x4*)(F.out + (size_t)r * D + c) = o; }
                else *(GAS f32x4*)(HO + (size_t)r * D + c) = o;
                if (a.write_u) { const f32x4 av = *(const GAS f32x4*)(mA + c), bb = *(const GAS f32x4*)(mB + c); const f32x4 u = o * (1.0f + av) + bb;
                    v2u w; w.x = pk2(u[0], u[1]); w.y = pk2(u[2], u[3]); *(GAS v2u*)(U + (size_t)r * D + c) = w; } } }
    }
}
__device__ __forceinline__ void ln_rows(Frame& F, int l, int k, float gate_scale, bool hin_input, int ln_idx, int lnx, int kn, bool write_u, bool final_out, int rows, bool dummy = false, bool ctx_parts = false) {
    const LnArgs a{l, k, ln_idx, lnx, kn, gate_scale, hin_input, write_u, final_out, dummy};
    ln_span<2, false>(F, a, 0, rows < ML ? rows : ML);
    if (rows > ML) { if (ctx_parts) ln_span<1, true>(F, a, ML, rows); else ln_span<1, false>(F, a, ML, rows); }
}
__device__ __forceinline__ void prep_phase(Frame& F, int l, int mode = 3) {
    const bf16* P = (const bf16*)(F.ws + WS_BIG); bf16* CV = (bf16*)(F.ws + WS_CV); const float* PN = (const float*)(F.ws + WS_PN);
    const int gt = blockIdx.x * (NWAVES * 64) + F.tid, NT = F.G * NWAVES * 64;
    if (mode & 1) {
        constexpr int NCG = CVW / 8;
        const int nx = (F.G % 8 == 0) ? 8 : 1, wpx = F.G / nx, xcd = (int)blockIdx.x % nx, wix = (int)blockIdx.x / nx;
        const int RS = (wpx * NWAVES * 64) / NCG;
        const int lt = wix * (NWAVES * 64) + F.tid, cg = lt % NCG, ch0 = cg * 8;
        const int rows_x = (M + nx - 1) / nx, rlo = xcd * rows_x, rhi = (rlo + rows_x < M) ? rlo + rows_x : M;
        const int rbeg = rlo + lt / NCG;
        if (lt / NCG < RS) {
            const float* w9; const float* bs; int wst;
            if (ch0 < 1536) { w9 = F.in[I_SCW] + (size_t)l * 9 * 1536 + ch0; bs = F.in[I_SCB] + l * 1536 + ch0; wst = 1536; }
            else { w9 = F.in[I_MCW] + (size_t)l * 9 * 1024 + (ch0 - 1536); bs = F.in[I_MCB] + l * 1024 + (ch0 - 1536); wst = 1024; }
            f32x4 wa[9], wb[9];
#pragma unroll
            for (int t9 = 0; t9 < 9; ++t9) { wa[t9] = *(const GAS f32x4*)(w9 + t9 * wst); wb[t9] = *(const GAS f32x4*)(w9 + t9 * wst + 4); }
            const f32x4 b0 = *(const GAS f32x4*)bs, b1 = *(const GAS f32x4*)(bs + 4);
            for (int r = rbeg; r < rhi; r += RS) {
                f32x4 a0 = b0, a1 = b1;
                const bf16* pin = P + (size_t)r * NWIDE + PC_XBC + ch0;
                if (r < ML) { const int t = r % SEQ, gr = t >> 6, gc = t & 63;
#pragma unroll
                    for (int dr = -1; dr <= 1; ++dr)
#pragma unroll
                        for (int dc = -1; dc <= 1; ++dc) { if (gr + dr < 0 || gr + dr > 63 || gc + dc < 0 || gc + dc > 63) continue;
                            const v4u xv = *(const GAS v4u*)(pin + (ptrdiff_t)(dr * 64 + dc) * NWIDE); const f32x4 w0 = wa[(dr + 1) * 3 + (dc + 1)], w1 = wb[(dr + 1) * 3 + (dc + 1)];
                            a0[0] += bflo(xv.x) * w0[0]; a0[1] += bfhi(xv.x) * w0[1]; a0[2] += bflo(xv.y) * w0[2]; a0[3] += bfhi(xv.y) * w0[3];
                            a1[0] += bflo(xv.z) * w1[0]; a1[1] += bfhi(xv.z) * w1[1]; a1[2] += bflo(xv.w) * w1[2]; a1[3] += bfhi(xv.w) * w1[3]; }
                } else { const int t = (r - ML) % CTXL;
#pragma unroll
                    for (int dc = -1; dc <= 1; ++dc) { if (t + dc < 0 || t + dc >= CTXL) continue;
                        const v4u xv = *(const GAS v4u*)(pin + (ptrdiff_t)dc * NWIDE); const f32x4 w0 = wa[3 + (dc + 1)], w1 = wb[3 + (dc + 1)];
                        a0[0] += bflo(xv.x) * w0[0]; a0[1] += bfhi(xv.x) * w0[1]; a0[2] += bflo(xv.y) * w0[2]; a0[3] += bfhi(xv.y) * w0[3];
                        a1[0] += bflo(xv.z) * w1[0]; a1[1] += bfhi(xv.z) * w1[1]; a1[2] += bflo(xv.w) * w1[2]; a1[3] += bfhi(xv.w) * w1[3]; }
                }
                v4u o; o.x = pk2(silu_f(a0[0]), silu_f(a0[1])); o.y = pk2(silu_f(a0[2]), silu_f(a0[3])); o.z = pk2(silu_f(a1[0]), silu_f(a1[1])); o.w = pk2(silu_f(a1[2]), silu_f(a1[3]));
                *(GAS v4u*)(CV + (size_t)r * CVW + ch0) = o;
            }
        }
    }
    float* DT = (float*)(F.ws + WS_DT); float* DA = (float*)(F.ws + WS_DA); float* MLG = (float*)(F.ws + WS_MLG); float* GD = (float*)(F.ws + WS_GD);
    if (mode & 2) {
        const int c = F.tid, d = c >> 8, j = c & 255;
        const float* w2 = F.in[I_GW2] + (size_t)(l * 2 + d) * 16 * 256 + j; const float b2 = F.in[I_GB2][(l * 2 + d) * 256 + j];
        float w2r[16];
#pragma unroll
        for (int q = 0; q < 16; ++q) w2r[q] = w2[q * 256];
        const float cb = c < 32 ? F.in[I_SDTB][l * 32 + c] : (c < 48 ? F.in[I_MGB][l * 16 + (c - 32)] : 0.f);
        const int pc = c < 32 ? c : (c < 48 ? 64 + (c - 32) : 0);
        int r = blockIdx.x;
        f32x4 n0, n1, n2, n3; float ns = 0.f;
        if (r < M) { const float* pn = PN + (size_t)r * 256; n0 = *(const GAS f32x4*)(pn + 32 + d * 16); n1 = *(const GAS f32x4*)(pn + 36 + d * 16); n2 = *(const GAS f32x4*)(pn + 40 + d * 16); n3 = *(const GAS f32x4*)(pn + 44 + d * 16); ns = pn[pc]; }
        for (; r < M; r += F.G) {
            const f32x4 l0 = n0, l1 = n1, l2 = n2, l3 = n3; const float sv = ns;
            const int rn = r + F.G;
            if (rn < M) { const float* pn = PN + (size_t)rn * 256; n0 = *(const GAS f32x4*)(pn + 32 + d * 16); n1 = *(const GAS f32x4*)(pn + 36 + d * 16); n2 = *(const GAS f32x4*)(pn + 40 + d * 16); n3 = *(const GAS f32x4*)(pn + 44 + d * 16); ns = pn[pc]; }
            float z = b2;
#pragma unroll
            for (int q = 0; q < 4; ++q) { z += l0[q] * w2r[q]; z += l1[q] * w2r[4 + q]; z += l2[q] * w2r[8 + q]; z += l3[q] * w2r[12 + q]; }
            const float ls = fminf(z, 0.f) - __logf(1.0f + __expf(-fabsf(z)));
            GD[(size_t)r * 512 + c] = ls * (1.0f / 16.0f);
            if (c < 32) DT[(size_t)r * 32 + c] = softplus_f(sv + cb);
            else if (c < 48) { const int i = c - 32; const float g = sv + cb;
                MLG[(size_t)r * 16 + i] = ((i >> 2) & 1) ? (fminf(g, 0.f) - log1pf(__expf(-fabsf(g)))) : g; }
        }
    }
}
#define LBAR() do { asm volatile("s_waitcnt lgkmcnt(0)" ::: "memory"); __builtin_amdgcn_s_barrier(); asm volatile("" ::: "memory"); } while (0)
typedef float f32x16 __attribute__((ext_vector_type(16)));
typedef short bf16x8v __attribute__((ext_vector_type(8)));
__device__ __forceinline__ void unpack8(const v4u w, float (&o)[8]) { o[0] = bflo(w.x); o[1] = bfhi(w.x); o[2] = bflo(w.y); o[3] = bfhi(w.y); o[4] = bflo(w.z); o[5] = bfhi(w.z); o[6] = bflo(w.w); o[7] = bfhi(w.w); }
template <int KS> __device__ __forceinline__ void mma_tile(f32x16& acc, const LAS unsigned char* A, int sa, int rA, const LAS unsigned char* B, int sb, int rB, int r, int h) {
    const LAS unsigned char* ap = A + (rA + r) * sa + 16 * h; const LAS unsigned char* bp = B + (rB + r) * sb + 16 * h;
#pragma unroll
    for (int s0 = 0; s0 < KS; s0 += 4) {
        bf16x8v a[4], b[4];
#pragma unroll
        for (int s = 0; s < 4; ++s) if (s0 + s < KS) { a[s] = *(const LAS bf16x8v*)(ap + 32 * (s0 + s)); b[s] = *(const LAS bf16x8v*)(bp + 32 * (s0 + s)); }
#pragma unroll
        for (int s = 0; s < 4; ++s) if (s0 + s < KS) acc = __builtin_amdgcn_mfma_f32_32x32x16_bf16(a[s], b[s], acc, 0, 0, 0);
    }
}
__device__ __forceinline__ void store_tile_T(const f32x16& acc, LAS unsigned char* img, int stride, int row0, int k0, int r, int h) {
#pragma unroll
    for (int g = 0; g < 4; ++g) { v2u w; w.x = pk2(acc[4 * g], acc[4 * g + 1]); w.y = pk2(acc[4 * g + 2], acc[4 * g + 3]);
        *(LAS v2u*)(img + (row0 + r) * stride + (k0 + 8 * g + 4 * h) * 2) = w; }
}
__device__ __forceinline__ float wave_incl_scan(float v, int lane) {
#pragma unroll
    for (int o = 1; o < 64; o <<= 1) { const float t = __shfl_up(v, o); if (lane >= o) v += t; }
    return v;
}
__device__ __forceinline__ int scan_chunk_row0(int b, int d, int c) {
    if (c < CTXL / 64) return ML + b * CTXL + 64 * (d ? CTXL / 64 - 1 - c : c);
    const int lc = c - CTXL / 64; return b * SEQ + 64 * (d ? SEQ / 64 - 1 - lc : lc);
}
template <int KIND> __device__ __forceinline__ void scan_chunked(Frame& F, int l, int task) {
    constexpr int DK = KIND == 1 ? 128 : 64, NVT = KIND == 0 ? 2 : (KIND == 1 ? 3 : 4), DVR = KIND == 2 ? 128 : 64, NKT = DK / 32;
    constexpr int NST = NKT * NVT, NOT = 2 * NVT, ST_PW = (NST + 7) / 8, OT_PW = (NOT + 7) / 8;
    constexpr int SQ = (DK + 8) * 2, SJ = 144;
    constexpr int O_QA = 0, O_KA = O_QA + 64 * SQ, O_VT = O_KA + 64 * SQ, O_KET = O_VT + NVT * 32 * SJ, O_AIM = O_KET + DK * SJ, O_STI = O_AIM + 64 * SJ, O_TAB = O_STI + NVT * 32 * SQ;
    constexpr int TABF = 64 * 6;
    static_assert(O_TAB + 2 * TABF * 4 <= RING_BYTES, "scan LDS");
    LAS unsigned char* L = F.lds;
    int tid_ = F.tid; asm volatile("" : "+v"(tid_));
    const int tid = tid_, lane = tid & 63, w = __builtin_amdgcn_readfirstlane(tid >> 6), r = lane & 31, h = lane >> 5;
    int b, d, hd; int vh = 0;
    if (KIND == 0) { b = task >> 5; d = (task >> 4) & 1; hd = task & 15; } else if (KIND == 1) { b = task >> 4; d = (task >> 3) & 1; hd = (task >> 1) & 3; vh = task & 1; } else { b = task >> 3; d = (task >> 2) & 1; hd = task & 3; }
    const bf16* CV = (const bf16*)(F.ws + WS_CV); const bf16* P = (const bf16*)(F.ws + WS_BIG);
    float* YS = (float*)(F.ws + WS_YS) + (size_t)d * M * D; float* DEN = (float*)(F.ws + WS_DEN) + (size_t)d * M * 4;
    const bf16 *qsrc, *ksrc, *vsrc; int qpitch, vpitch, ycol;
    if (KIND == 0) { qsrc = CV + 1280 + (hd >> 2) * 64; ksrc = CV + 1024 + (hd >> 2) * 64; vsrc = CV + hd * 64; qpitch = CVW; vpitch = CVW; ycol = hd * 64; }
    else if (KIND == 1) { qsrc = CV + 1536 + hd * 128; ksrc = CV + 2048 + hd * 128; vsrc = P + PC_MV + hd * 128 + vh * 64; qpitch = CVW; vpitch = NWIDE; ycol = 1024 + hd * 128 + vh * 64; }
    else { qsrc = P + PC_GQ + hd * 64; ksrc = P + PC_GK + hd * 64; vsrc = P + PC_GV + hd * 128; qpitch = NWIDE; vpitch = NWIDE; ycol = 1536 + hd * 128; }
    const float* sc1; float aneg = 0.f;
    if (KIND == 0) { sc1 = (const float*)(F.ws + WS_DT) + d * 16 + hd; aneg = -__expf(F.in[I_SALOG][l * 32 + d * 16 + hd]); }
    else sc1 = (const float*)(F.ws + WS_MLG) + d * 8 + hd;
    const float* gdsrc = (const float*)(F.ws + WS_GD) + d * 256 + hd * 64;
    const int pr = tid & 31, grp = tid >> 5;
    const bool isq = (DK == 128) || grp < 8;
    const int qkg = (DK == 128) ? grp : (grp & 7);
    const bool hasv = (DVR == 128) || grp < 8;
    constexpr int TW = 7;
    int sti[ST_PW], oti[OT_PW];
#pragma unroll
    for (int s = 0; s < ST_PW; ++s) { const int i = (KIND == 0) ? (w >= 4 ? w - 4 : NST) : (w + 8 * s); sti[s] = (i < NST) ? i : -1; }
#pragma unroll
    for (int s = 0; s < OT_PW; ++s) { const int i = (KIND == 0) ? (w < 4 ? w : NOT) : (w + 8 * s); oti[s] = (i < NOT) ? i : -1; }
    const int p1i = (KIND == 1) ? (w >= 4 ? w - 4 : -1) : (w < 4 ? w : -1);
    f32x16 st[ST_PW];
#pragma unroll
    for (int s = 0; s < ST_PW; ++s)
#pragma unroll
        for (int i = 0; i < 16; ++i) st[s][i] = 0.f;
    for (int i = tid; i < NVT * 32 * SQ / 4; i += NWAVES * 64) ((LAS unsigned*)(L + O_STI))[i] = 0u;
    if (KIND == 1) for (int i = tid; i < 32 * SJ / 4; i += NWAVES * 64) ((LAS unsigned*)(L + O_VT + 64 * SJ))[i] = (i < SJ / 4) ? 0x3f803f80u : 0u;
    v4u rq[2], rk[2], rv[2]; float rs1 = 0.f, rs2 = 0.f; f32x4 rg[4];
    constexpr int NCH = (CTXL + SEQ) / 64;
    f32x16 ohold[OT_PW]; int orow0 = 0;
#define SCAN_STORE_OUT() do { _Pragma("unroll") for (int s = 0; s < OT_PW; ++s) if (oti[s] >= 0) { const int tt = oti[s] & 1, vt = oti[s] >> 1; \
        _Pragma("unroll") for (int i = 0; i < 16; ++i) { const int t = 32 * tt + (i & 3) + 8 * (i >> 2) + 4 * h; \
            if (KIND == 1 && vt == 2) { if (r == 0 && vh == 0) DEN[(size_t)(orow0 + t) * 4 + hd] = ohold[s][i]; } \
            else YS[(size_t)(orow0 + t) * D + ycol + 32 * vt + r] = ohold[s][i]; } } } while (0)
#define SCAN_PREFETCH(ROW0) do { const size_t r0_ = (size_t)((ROW0) + 2 * pr), r1_ = r0_ + 1; \
        if (DK == 128) { rq[0] = *(const GAS v4u*)(qsrc + r0_ * qpitch + 8 * qkg); rq[1] = *(const GAS v4u*)(qsrc + r1_ * qpitch + 8 * qkg); rk[0] = *(const GAS v4u*)(ksrc + r0_ * qpitch + 8 * qkg); rk[1] = *(const GAS v4u*)(ksrc + r1_ * qpitch + 8 * qkg); } \
        else { const bf16* sp_ = isq ? qsrc : ksrc; rq[0] = *(const GAS v4u*)(sp_ + r0_ * qpitch + 8 * qkg); rq[1] = *(const GAS v4u*)(sp_ + r1_ * qpitch + 8 * qkg); } \
        if (hasv) { rv[0] = *(const GAS v4u*)(vsrc + r0_ * vpitch + 8 * grp); rv[1] = *(const GAS v4u*)(vsrc + r1_ * vpitch + 8 * grp); } \
        if (KIND != 2) { if (w == TW) { rs1 = sc1[(size_t)((ROW0) + lane) * (KIND == 0 ? 32 : 16)]; if (KIND == 1) rs2 = sc1[(size_t)((ROW0) + lane) * 16 + 4]; } } \
        else { rg[0] = *(const GAS f32x4*)(gdsrc + r0_ * 512 + 8 * qkg); rg[1] = *(const GAS f32x4*)(gdsrc + r0_ * 512 + 8 * qkg + 4); rg[2] = *(const GAS f32x4*)(gdsrc + r1_ * 512 + 8 * qkg); rg[3] = *(const GAS f32x4*)(gdsrc + r1_ * 512 + 8 * qkg + 4); } \
    } while (0)
#define SCAN_TABLES(SET) do { constexpr float L2E = 1.4426950408889634f; LAS float* T_ = (LAS float*)(L + O_TAB) + (SET) * TABF; \
        const float lg_ = (KIND == 0) ? rs1 * aneg : rs2; const float inc_ = wave_incl_scan(lg_, lane), tot_ = __shfl(inc_, 63); \
        const float cs_ = d ? (tot_ - inc_ + lg_) : inc_; const float ii_ = (KIND == 1) ? rs1 : 0.f; \
        T_[lane] = cs_ * L2E; T_[64 + lane] = (cs_ - ii_) * L2E; T_[128 + lane] = (KIND == 0) ? rs1 : 1.f; \
        T_[192 + lane] = __expf(cs_); T_[256 + lane] = __expf(tot_ - cs_ + ii_) * ((KIND == 0) ? rs1 : 1.f); if (lane == 0) T_[320] = __expf(tot_); } while (0)
    SCAN_PREFETCH(scan_chunk_row0(b, d, 0));
    if (KIND != 2 && w == TW) SCAN_TABLES(0);
    LBAR();
    for (int c = 0; c < NCH; ++c) {
        const int row0 = scan_chunk_row0(b, d, c);
        LAS float* T1 = (LAS float*)(L + O_TAB) + (KIND == 2 ? 0 : (c & 1) * TABF); LAS float* T2 = T1 + 64; LAS float* T3 = T2 + 64; LAS float* ET = T3 + 64; LAS float* EJ = ET + 64; LAS float* DEC = EJ + 64;
        {
            const int t0 = 2 * pr, t1 = t0 + 1;
            float a0[8], a1[8];
            if (DK == 128) {
                unpack8(rq[0], a0); unpack8(rq[1], a1); const float qs = 0.08838834764831845f;
                v4u o0, o1; o0.x = pk2(a0[0] * qs, a0[1] * qs); o0.y = pk2(a0[2] * qs, a0[3] * qs); o0.z = pk2(a0[4] * qs, a0[5] * qs); o0.w = pk2(a0[6] * qs, a0[7] * qs);
                o1.x = pk2(a1[0] * qs, a1[1] * qs); o1.y = pk2(a1[2] * qs, a1[3] * qs); o1.z = pk2(a1[4] * qs, a1[5] * qs); o1.w = pk2(a1[6] * qs, a1[7] * qs);
                *(LAS v4u*)(L + O_QA + t0 * SQ + 16 * qkg) = o0; *(LAS v4u*)(L + O_QA + t1 * SQ + 16 * qkg) = o1;
                *(LAS v4u*)(L + O_KA + t0 * SQ + 16 * qkg) = rk[0]; *(LAS v4u*)(L + O_KA + t1 * SQ + 16 * qkg) = rk[1];
                unpack8(rk[0], a0); unpack8(rk[1], a1); const float e0 = EJ[t0], e1 = EJ[t1];
#pragma unroll
                for (int e = 0; e < 8; ++e) *(LAS unsigned*)(L + O_KET + (8 * qkg + e) * SJ + 4 * pr) = pk2(a0[e] * e0, a1[e] * e1);
            } else if (KIND == 0) {
                if (isq) { *(LAS v4u*)(L + O_QA + t0 * SQ + 16 * qkg) = rq[0]; *(LAS v4u*)(L + O_QA + t1 * SQ + 16 * qkg) = rq[1]; }
                else { *(LAS v4u*)(L + O_KA + t0 * SQ + 16 * qkg) = rq[0]; *(LAS v4u*)(L + O_KA + t1 * SQ + 16 * qkg) = rq[1];
                    unpack8(rq[0], a0); unpack8(rq[1], a1); const float e0 = EJ[t0], e1 = EJ[t1];
#pragma unroll
                    for (int e = 0; e < 8; ++e) *(LAS unsigned*)(L + O_KET + (8 * qkg + e) * SJ + 4 * pr) = pk2(a0[e] * e0, a1[e] * e1); }
            } else {
                float la0[8], la1[8], c0[8], c1[8], tot[8];
#pragma unroll
                for (int e = 0; e < 4; ++e) { la0[e] = rg[0][e]; la0[4 + e] = rg[1][e]; la1[e] = rg[2][e]; la1[4 + e] = rg[3][e]; }
#pragma unroll
                for (int e = 0; e < 8; ++e) { const float sp = la0[e] + la1[e]; float inc = sp;
#pragma unroll
                    for (int o = 1; o < 32; o <<= 1) { const float tv = __shfl_up(inc, o, 32); if (pr >= o) inc += tv; }
                    tot[e] = __shfl(inc, 31, 32);
                    if (!d) { c1[e] = inc; c0[e] = inc - la1[e]; } else { const float suf = tot[e] - inc + sp; c0[e] = suf; c1[e] = suf - la0[e]; } }
                unpack8(rq[0], a0); unpack8(rq[1], a1);
                if (isq) { float q0[8], q1[8];
#pragma unroll
                    for (int e = 0; e < 8; ++e) { q0[e] = a0[e] * 0.125f * __expf(c0[e]); q1[e] = a1[e] * 0.125f * __expf(c1[e]); }
                    v4u o0, o1; o0.x = pk2(q0[0], q0[1]); o0.y = pk2(q0[2], q0[3]); o0.z = pk2(q0[4], q0[5]); o0.w = pk2(q0[6], q0[7]); o1.x = pk2(q1[0], q1[1]); o1.y = pk2(q1[2], q1[3]); o1.z = pk2(q1[4], q1[5]); o1.w = pk2(q1[6], q1[7]);
                    *(LAS v4u*)(L + O_QA + t0 * SQ + 16 * qkg) = o0; *(LAS v4u*)(L + O_QA + t1 * SQ + 16 * qkg) = o1;
                } else { float k0[8], k1[8];
#pragma unroll
                    for (int e = 0; e < 8; ++e) { k0[e] = a0[e] * __expf(-c0[e]); k1[e] = a1[e] * __expf(-c1[e]); }
                    v4u o0, o1; o0.x = pk2(k0[0], k0[1]); o0.y = pk2(k0[2], k0[3]); o0.z = pk2(k0[4], k0[5]); o0.w = pk2(k0[6], k0[7]); o1.x = pk2(k1[0], k1[1]); o1.y = pk2(k1[2], k1[3]); o1.z = pk2(k1[4], k1[5]); o1.w = pk2(k1[6], k1[7]);
                    *(LAS v4u*)(L + O_KA + t0 * SQ + 16 * qkg) = o0; *(LAS v4u*)(L + O_KA + t1 * SQ + 16 * qkg) = o1;
#pragma unroll
                    for (int e = 0; e < 8; ++e) *(LAS unsigned*)(L + O_KET + (8 * qkg + e) * SJ + 4 * pr) = pk2(a0[e] * __expf(tot[e] - c0[e]), a1[e] * __expf(tot[e] - c1[e]));
                    if (pr == 0) {
#pragma unroll
                        for (int e = 0; e < 8; ++e) DEC[8 * qkg + e] = __expf(tot[e]); } }
            }
            if (hasv) { unpack8(rv[0], a0); unpack8(rv[1], a1);
#pragma unroll
                for (int e = 0; e < 8; ++e) *(LAS unsigned*)(L + O_VT + (8 * grp + e) * SJ + 4 * pr) = pk2(a0[e], a1[e]); }
        }
        if (c + 1 < NCH) SCAN_PREFETCH(scan_chunk_row0(b, d, c + 1));
        if (c > 0) SCAN_STORE_OUT();
        LBAR();
#pragma unroll
        for (int s = 0; s < ST_PW; ++s) if (sti[s] >= 0) { const int kt = sti[s] % NKT, vt = sti[s] / NKT;
            if (KIND == 2) {
#pragma unroll
                for (int g = 0; g < 4; ++g) { const f32x4 dv = *(const LAS f32x4*)(DEC + 32 * kt + 8 * g + 4 * h);
#pragma unroll
                    for (int e = 0; e < 4; ++e) st[s][4 * g + e] *= dv[e]; }
            } else { const float dv = DEC[0];
#pragma unroll
                for (int i = 0; i < 16; ++i) st[s][i] *= dv; }
            mma_tile<4>(st[s], L + O_KET, SJ, 32 * kt, L + O_VT, SJ, 32 * vt, r, h); }
        if (p1i >= 0) { const int jt = p1i & 1, tt = p1i >> 1;
            f32x16 a;
#pragma unroll
            for (int i = 0; i < 16; ++i) a[i] = 0.f;
            mma_tile<DK / 16>(a, L + O_KA, SQ, 32 * jt, L + O_QA, SQ, 32 * tt, r, h);
            const int t = 32 * tt + r; const float t1v = (KIND == 2) ? 0.f : T1[t];
#pragma unroll
            for (int g = 0; g < 4; ++g) { const int jb = 32 * jt + 8 * g + 4 * h;
                f32x4 t2 = {0.f, 0.f, 0.f, 0.f}, t3 = {1.f, 1.f, 1.f, 1.f};
                if (KIND != 2) { t2 = *(const LAS f32x4*)(T2 + jb); if (KIND == 0) t3 = *(const LAS f32x4*)(T3 + jb); }
#pragma unroll
                for (int e = 0; e < 4; ++e) { const int j = jb + e; const bool keep = d ? (j >= t) : (j <= t);
                    const float wv = (KIND == 2) ? 1.f : __builtin_amdgcn_exp2f(t1v - t2[e]) * t3[e];
                    a[4 * g + e] = keep ? a[4 * g + e] * wv : 0.f; } }
            store_tile_T(a, L + O_AIM, SJ, 32 * tt, 32 * jt, r, h); }
        LBAR();
#pragma unroll
        for (int s = 0; s < OT_PW; ++s) if (oti[s] >= 0) { const int tt = oti[s] & 1, vt = oti[s] >> 1;
            f32x16 o1, o2;
#pragma unroll
            for (int i = 0; i < 16; ++i) { o1[i] = 0.f; o2[i] = 0.f; }
            mma_tile<4>(o1, L + O_AIM, SJ, 32 * tt, L + O_VT, SJ, 32 * vt, r, h);
            mma_tile<DK / 16>(o2, L + O_QA, SQ, 32 * tt, L + O_STI, SQ, 32 * vt, r, h);
#pragma unroll
            for (int g = 0; g < 4; ++g) { f32x4 ev = {1.f, 1.f, 1.f, 1.f}; if (KIND != 2) ev = *(const LAS f32x4*)(ET + 32 * tt + 8 * g + 4 * h);
#pragma unroll
                for (int e = 0; e < 4; ++e) ohold[s][4 * g + e] = o1[4 * g + e] + ev[e] * o2[4 * g + e]; } }
        orow0 = row0;
        if (KIND != 2 && w == TW && c + 1 < NCH) SCAN_TABLES((c + 1) & 1);
        LBAR();
#pragma unroll
        for (int s = 0; s < ST_PW; ++s) if (sti[s] >= 0) { const int kt = sti[s] % NKT, vt = sti[s] / NKT; store_tile_T(st[s], L + O_STI, SQ, 32 * vt, 32 * kt, r, h); }
    }
    SCAN_STORE_OUT();
#undef SCAN_PREFETCH
#undef SCAN_STORE_OUT
#undef SCAN_TABLES
    LBAR();
}
__device__ __forceinline__ void scan_phase(Frame& F, int l) {
    for (int t = blockIdx.x; t < 224; t += F.G) {
        if (t < 128) { scan_chunked<0>(F, l, t); if (PROBE & 8192) scan_chunked<0>(F, l, t); }
        else if (t < 192) { scan_chunked<1>(F, l, t - 128); if (PROBE & 16384) scan_chunked<1>(F, l, t - 128); }
        else { scan_chunked<2>(F, l, t - 192); if (PROBE & 32768) scan_chunked<2>(F, l, t - 192); }
    }
}
__device__ __forceinline__ void finish_phase(Frame& F, int l, int rows) {
    const bf16* P = (const bf16*)(F.ws + WS_BIG); const bf16* CV = (const bf16*)(F.ws + WS_CV); const float* Y0 = (const float*)(F.ws + WS_YS); const float* Y1 = Y0 + (size_t)M * D; bf16* ABR = (bf16*)(F.ws + WS_U);
    const float* DEN0 = (const float*)(F.ws + WS_DEN); const float* DEN1 = DEN0 + (size_t)M * 4;
    const float* dsk = F.in[I_SD] + l * 16; const float* snw = F.in[I_SNW] + l * 1024; const float* mnw = F.in[I_MNW] + l * 512; const float* gnw = F.in[I_GNW] + l * 512;
    for (int r = F.gw; r < rows; r += F.NGW) {
#pragma unroll
        for (int j = 0; j < 4; ++j) { const int c = 256 * j + 4 * F.lane; const f32x4 ya = *(const GAS f32x4*)(Y0 + (size_t)r * D + c), yb = *(const GAS f32x4*)(Y1 + (size_t)r * D + c);
            const v2u xw = *(const GAS v2u*)(CV + (size_t)r * CVW + c), zw = *(const GAS v2u*)(P + (size_t)r * NWIDE + PC_Z + c); const float ds = dsk[c >> 6];
            f32x4 y; y[0] = (ya[0] + yb[0] + ds * bflo(xw.x)) * silu_f(bflo(zw.x)); y[1] = (ya[1] + yb[1] + ds * bfhi(xw.x)) * silu_f(bfhi(zw.x));
            y[2] = (ya[2] + yb[2] + ds * bflo(xw.y)) * silu_f(bflo(zw.y)); y[3] = (ya[3] + yb[3] + ds * bfhi(xw.y)) * silu_f(bfhi(zw.y));
            const float ssq = wave_sum((y[0] * y[0] + y[1] * y[1]) + (y[2] * y[2] + y[3] * y[3])); const float rs = 1.f / sqrtf(ssq * (1.f / 256.f) + EPS);
            const f32x4 w = *(const GAS f32x4*)(snw + c); v2u o; o.x = pk2(y[0] * rs * w[0], y[1] * rs * w[1]); o.y = pk2(y[2] * rs * w[2], y[3] * rs * w[3]);
            *(GAS v2u*)(ABR + (size_t)r * D + c) = o; }
#pragma unroll
        for (int j = 0; j < 4; ++j) { const int cl = 256 * (j & 1) + 4 * F.lane, c = (j < 2 ? 1024 : 1536) + cl;
            const f32x4 ya = *(const GAS f32x4*)(Y0 + (size_t)r * D + c), yb = *(const GAS f32x4*)(Y1 + (size_t)r * D + c);
            const v2u gw = *(const GAS v2u*)(P + (size_t)r * NWIDE + (j < 2 ? PC_MO : PC_GR) + cl);
            f32x4 y = ya + yb;
            if (j < 2) { const int hd_ = cl >> 7; const float d0 = fmaxf(fabsf(DEN0[(size_t)r * 4 + hd_]), 1.0f), d1 = fmaxf(fabsf(DEN1[(size_t)r * 4 + hd_]), 1.0f); y = ya / d0 + yb / d1; }
            if (j < 2) { y[0] *= sigm_f(bflo(gw.x)); y[1] *= sigm_f(bfhi(gw.x)); y[2] *= sigm_f(bflo(gw.y)); y[3] *= sigm_f(bfhi(gw.y)); }
            const float mean = half_sum((y[0] + y[1]) + (y[2] + y[3])) * (1.f / 128.f); y = y - mean;
            const float var = half_sum((y[0] * y[0] + y[1] * y[1]) + (y[2] * y[2] + y[3] * y[3])) * (1.f / 128.f); const float rs = 1.f / sqrtf(var + EPS);
            const f32x4 w = *(const GAS f32x4*)((j < 2 ? mnw : gnw) + cl); y = y * rs * w;
            if (j >= 2) { y[0] *= silu_f(bflo(gw.x)); y[1] *= silu_f(bfhi(gw.x)); y[2] *= silu_f(bflo(gw.y)); y[3] *= silu_f(bfhi(gw.y)); }
            v2u o; o.x = pk2(y[0], y[1]); o.y = pk2(y[2], y[3]); *(GAS v2u*)(ABR + (size_t)r * D + c) = o; }
    }
}

constexpr int PH_PER_LAYER = 13, N_PHASES = 2 + PH_PER_LAYER * DEPTH;
__global__ void __launch_bounds__(NWAVES * 64, 2) mk_fwd(Args args) {
    extern __shared__ __attribute__((aligned(16))) unsigned char lds_[];
    LAS unsigned char* lds = (LAS unsigned char*)lds_;
    volatile LAS unsigned* MISC = (volatile LAS unsigned*)(lds + MISC_OFF);
    for (int u = threadIdx.x; u < (LDS_BYTES - LDSCTL_OFF) / 4; u += NWAVES * 64) ((LAS unsigned*)(lds + LDSCTL_OFF))[u] = 0u;
    __syncthreads();
    XcdBarrier bar; bar.bar = (unsigned*)(args.ws + WS_CTL) + CW_BAR; bar.x = 0; bar.st = nullptr;
    if (!MK_PER_PHASE) bar = xcd_barrier_post((unsigned*)(args.ws + WS_CTL) + CW_BAR, MISC + 8);
    const int lo = args.ph_lo, hi = args.ph_hi;
#define IN(k) (lo <= (k) && (k) < hi)
#define SEAM(k) do { if (IN(k) && IN((k) + 1)) xcd_barrier(bar); } while (0)
#define GEMM_CALL(EPI, Aptr, Bptr, Mr, Nn, Kk, LDA, LDB, ...) do { pg8::Gemm g{Aptr, Bptr, Mr, Nn, Kk, LDA, LDB}; pg8::StaticOrder S; S.init(Mr, Nn, F.G, (int)blockIdx.x); EPI E{__VA_ARGS__}; \
        pg8::gemm_phase<EPI, pg8::StaticOrder, PG8_ALIGN, PG8_SP2>(F.lds + RING_OFF, g, S, E); } while (0)
#define PIECE_CALL(Aptr, Bptr, Mr, Nn, Kslice, LDA, LDB, KS, ...) do { pg8::Gemm g{Aptr, Bptr, Mr, Nn, Kslice, LDA, LDB}; pg8::PieceOrder S; S.init(Mr, Nn, KS, (Kslice) * 2, F.G, (int)blockIdx.x); pg8::EpiF32Part E{__VA_ARGS__}; \
        pg8::gemm_phase<pg8::EpiF32Part, pg8::PieceOrder, PG8_ALIGN, PG8_SP2>(F.lds + RING_OFF, g, S, E); } while (0)
#define REP(bit) for (int rep_ = 0; rep_ < ((PROBE & (bit)) ? 2 : 1); ++rep_)
#define WSP(T, off) ((T*)(F.ws + (off)))

    if (IN(0)) { REP(128) { Frame F = mkframe(lds); mod_phase(F); } REP(8) { Frame F = mkframe(lds); convert_weights(F, 0); __syncthreads(); } } SEAM(0);
    if (IN(1)) { Frame F = mkframe(lds); modulate_rows(F, 0, 0, M); } SEAM(1);
    for (int l = 0; l < DEPTH; ++l) {
        const int pb = 2 + PH_PER_LAYER * l;
        const bool lastl = (l == DEPTH - 1);
        const int Mtail = lastl ? ML : M;
        if (IN(pb + 0)) { if (PROBE & 65536) { Frame F = mkframe(lds); GEMM_CALL(pg8::EpiNull, WSP(bf16, WS_U), WSP(bf16, WS_WB + WB_FIN), M, NFF, D, D, D, 0); } REP(256) { Frame F = mkframe(lds); GEMM_CALL(pg8::EpiSwiGLU, WSP(bf16, WS_U), WSP(bf16, WS_WB + WB_FIN), M, NFF, D, D, D, WSP(bf16, WS_BIG), DFF); } } SEAM(pb + 0);
        if (IN(pb + 1)) REP(512) { { Frame F = mkframe(lds); GEMM_CALL(pg8::EpiBf16, WSP(bf16, WS_BIG), WSP(bf16, WS_WB + WB_FOUT), ML, D, DFF, DFF, DFF, WSP(bf16, WS_Y), D); }
            { Frame F = mkframe(lds); PIECE_CALL(WSP(bf16, WS_BIG) + (size_t)ML * DFF, WSP(bf16, WS_WB + WB_FOUT), MC, D, DFF / 4, DFF, DFF, 4, WSP(float, WS_YP), D, (size_t)MC * D); } } SEAM(pb + 1);
        if (IN(pb + 2)) { if (PROBE & 16) { Frame F = mkframe(lds); ln_rows(F, l, 0, 0.5f, l == 0, 0, l, 1, true, false, M, true, true); } Frame F = mkframe(lds); ln_rows(F, l, 0, 0.5f, l == 0, 0, l, 1, true, false, M, false, true); } SEAM(pb + 2);
        if (IN(pb + 3)) REP(1024) { Frame F = mkframe(lds); GEMM_CALL(pg8::EpiInProj, WSP(bf16, WS_U), WSP(bf16, WS_WB + WB_WIN), M, NIN, D, D, D, WSP(bf16, WS_BIG), NWIDE, WSP(float, WS_PN), NWIDE / 256); } SEAM(pb + 3);
        if (IN(pb + 4)) { if (PROBE & 4) { Frame F = mkframe(lds); prep_phase(F, l, 1); } if (PROBE & 32) { Frame F = mkframe(lds); prep_phase(F, l, 2); } Frame F = mkframe(lds); prep_phase(F, l); } SEAM(pb + 4);
        if (IN(pb + 5)) REP(1) { Frame F = mkframe(lds); scan_phase(F, l); } SEAM(pb + 5);
        if (IN(pb + 6)) REP(64) { Frame F = mkframe(lds); finish_phase(F, l, Mtail); } SEAM(pb + 6);
        if (IN(pb + 7)) REP(2048) {
            { Frame F = mkframe(lds); const float* mb = F.in[I_MERGEB] + (size_t)l * 3 * D;
              GEMM_CALL(pg8::EpiBranch<0>, WSP(bf16, WS_U), WSP(bf16, WS_WB + WB_BRS), Mtail, D, 1024, D, 1024, WSP(bf16, WS_BIG) + PC_GATE, NWIDE, mb, WSP(float, WS_YS), WSP(bf16, WS_CV), D); }
            { Frame F = mkframe(lds); const float* mb = F.in[I_MERGEB] + (size_t)l * 3 * D + D;
              GEMM_CALL(pg8::EpiBranch<1>, WSP(bf16, WS_U) + 1024, WSP(bf16, WS_WB + WB_BRM), Mtail, D, 512, D, 512, WSP(bf16, WS_BIG) + PC_GATE + D, NWIDE, mb, WSP(float, WS_YS), WSP(bf16, WS_CV), D); }
            { Frame F = mkframe(lds); const float* mb = F.in[I_MERGEB] + (size_t)l * 3 * D + 2 * D;
              GEMM_CALL(pg8::EpiBranch<2>, WSP(bf16, WS_U) + 1536, WSP(bf16, WS_WB + WB_BRG), Mtail, D, 512, D, 512, WSP(bf16, WS_BIG) + PC_GATE + 2 * D, NWIDE, mb, WSP(float, WS_YS), WSP(bf16, WS_CV), D); }
        } SEAM(pb + 7);
        if (IN(pb + 8)) REP(4096) { Frame F = mkframe(lds); GEMM_CALL(pg8::EpiBf16, WSP(bf16, WS_CV), WSP(bf16, WS_WB + WB_OUT), Mtail, D, D, D, D, WSP(bf16, WS_Y), D); } SEAM(pb + 8);
        if (IN(pb + 9)) { if (PROBE & 16) { Frame F = mkframe(lds); ln_rows(F, l, 1, 1.0f, false, 1, l, 2, true, false, Mtail, true); } Frame F = mkframe(lds); ln_rows(F, l, 1, 1.0f, false, 1, l, 2, true, false, Mtail); } SEAM(pb + 9);
        if (IN(pb + 10)) REP(256) { Frame F = mkframe(lds); GEMM_CALL(pg8::EpiSwiGLU, WSP(bf16, WS_U), WSP(bf16, WS_WB + WB_FIN) + (size_t)NFF * D, Mtail, NFF, D, D, D, WSP(bf16, WS_BIG), DFF); } SEAM(pb + 10);
        if (IN(pb + 11)) REP(512) { { Frame F = mkframe(lds); GEMM_CALL(pg8::EpiBf16, WSP(bf16, WS_BIG), WSP(bf16, WS_WB + WB_FOUT) + (size_t)D * DFF, ML, D, DFF, DFF, DFF, WSP(bf16, WS_Y), D); }
            if (!lastl) { Frame F = mkframe(lds); PIECE_CALL(WSP(bf16, WS_BIG) + (size_t)ML * DFF, WSP(bf16, WS_WB + WB_FOUT) + (size_t)D * DFF, MC, D, DFF / 4, DFF, DFF, 4, WSP(float, WS_YP), D, (size_t)MC * D); } } SEAM(pb + 11);
        if (IN(pb + 12)) { if (PROBE & 16) { Frame F = mkframe(lds); ln_rows(F, l, 2, 0.5f, false, 2, lastl ? l : l + 1, 0, !lastl, lastl, Mtail, true, true); } Frame F = mkframe(lds); ln_rows(F, l, 2, 0.5f, false, 2, lastl ? l : l + 1, 0, !lastl, lastl, Mtail, false, true);
            if (!lastl) REP(8) { convert_weights(F, l + 1); __syncthreads(); } } SEAM(pb + 12);
    }
#undef IN
#undef SEAM
}

extern "C" void kernel_launch(void* const* d_in, const int* in_sizes, int n_in, void* d_out, int out_size, void* d_ws, size_t ws_size, hipStream_t stream) {
    static int grid = 0;
    if (grid == 0) {
        if (n_in != 29 || in_sizes[0] != ML * D || out_size != ML * D || ws_size < WS_END) { fprintf(stderr, "kernel_launch: unexpected shapes (n_in %d, out %d, ws %zu, need %zu); nothing launched\n", n_in, out_size, ws_size, (size_t)WS_END); grid = -1; return; }
        int dev = 0, cus = 0, per_cu = 0;
        if (hipGetDevice(&dev) != hipSuccess || hipDeviceGetAttribute(&cus, hipDeviceAttributeMultiprocessorCount, dev) != hipSuccess) { fprintf(stderr, "kernel_launch: device query failed\n"); grid = -1; return; }
        if (hipFuncSetAttribute((const void*)mk_fwd, hipFuncAttributeMaxDynamicSharedMemorySize, LDS_BYTES) != hipSuccess) { fprintf(stderr, "kernel_launch: hipFuncSetAttribute failed\n"); grid = -1; return; }
        if (hipOccupancyMaxActiveBlocksPerMultiprocessor(&per_cu, (const void*)mk_fwd, NWAVES * 64, LDS_BYTES) != hipSuccess || per_cu < 1)
            fprintf(stderr, "kernel_launch: note: occupancy query reports %d workgroups per CU\n", per_cu);
        (void)hipGetLastError();
        grid = cus;
    }
    if (grid < 0) return;
    if (hipMemsetAsync((char*)d_ws + WS_CTL, 0, CTL_ZERO_BYTES, stream) != hipSuccess) { fprintf(stderr, "kernel_launch: memset failed\n"); return; }
    Args a{};
    for (int i = 0; i < 29; ++i) a.in[i] = (const float*)d_in[i];
    a.out = (float*)d_out; a.ws = (unsigned char*)d_ws;
#if MK_PER_PHASE
    for (int ph = 0; ph < N_PHASES; ++ph) { a.ph_lo = ph; a.ph_hi = ph + 1; hipLaunchKernelGGL(mk_fwd, dim3(grid), dim3(NWAVES * 64), LDS_BYTES, stream, a); }
#else
    a.ph_lo = 0; a.ph_hi = N_PHASES;
    hipLaunchKernelGGL(mk_fwd, dim3(grid), dim3(NWAVES * 64), LDS_BYTES, stream, a);
#endif
    const hipError_t le = hipPeekAtLastError();
    if (le != hipSuccess) fprintf(stderr, "kernel_launch: launch failed: %s\n", hipGetErrorName(le));
}
```

```cpp
#include <hip/hip_runtime.h>
#include <cstdio>
#include <cstdint>

#ifndef MK_PER_PHASE
#define MK_PER_PHASE 0
#endif
#ifndef PROBE_T
#define PROBE_T 0
#endif
#ifndef PROBE_TSEL
#define PROBE_TSEL -1
#endif
#ifndef PROBE_TB
#define PROBE_TB 0
#endif
#ifndef PROBE_BLK
#define PROBE_BLK -1
#endif
#ifndef PROBE_BSTAT
#define PROBE_BSTAT 1
#endif
#ifndef PROBE
#define PROBE 0
#endif

namespace pg8 {
#define PG8_LAS __attribute__((address_space(3)))
typedef unsigned short bf16_t;
typedef short bf16x8 __attribute__((ext_vector_type(8)));
typedef float f32x4 __attribute__((ext_vector_type(4)));
typedef unsigned u32x4 __attribute__((ext_vector_type(4)));
constexpr int BM = 256, BK = 64, HALF = 128, HTB = HALF * BK * 2, STAGE_BYTES = 8 * HTB, NXCD = 8, WGM = 8;

__host__ __device__ __forceinline__ int lds_byte(int r, int c) { const int st = (r >> 4) * 2 + (c >> 5), rr = r & 15, cc = c & 31, ob = rr * 64 + cc * 2; return st * 1024 + (ob ^ (((ob >> 9) & 1) << 5)); }
__host__ __device__ __forceinline__ void stage_rc(int b, int& R, int& C) { const int st = b / 1024, sb = b % 1024, swz = sb ^ (((sb >> 9) & 1) << 5); R = (st >> 1) * 16 + swz / 64; C = (st & 1) * 32 + (swz % 64) / 2; }
__host__ __device__ __forceinline__ int perm32(int rho) { const int n = rho >> 4, i = rho & 15; return 8 * (i >> 2) + 4 * n + (i & 3); }

struct Unit { int pm, pn, koff, part, nt; };
struct Gemm { const bf16_t* A; const bf16_t* Bt; int M, N, K, lda, ldb; };

struct StaticOrder {
    int nM, nN, nwg, G, c;
    __host__ __device__ void init(int M, int N, int G_, int c_) { nM = M / BM; nN = N / BM; nwg = nM * nN; G = G_; c = c_; }
    __host__ __device__ bool next(int i, Unit& u) const {
        const long L = (long)i * G + c; if (L >= nwg) return false;
        int wgid = (int)L; { const int q = nwg / NXCD, r = nwg % NXCD, xcd = wgid % NXCD, off = wgid / NXCD; wgid = (xcd < r ? xcd * (q + 1) : r * (q + 1) + (xcd - r) * q) + off; }
        const int nig = WGM * nN, gid = wgid / nig, fm = gid * WGM, gsz = (nM - fm) < WGM ? (nM - fm) : WGM;
        u.pm = fm + ((wgid % nig) % gsz); u.pn = (wgid % nig) / gsz; u.koff = 0; u.part = 0; u.nt = 0; return true;
    }
    __device__ __forceinline__ void a_ready(const Unit&) const {}
    __device__ __forceinline__ void done(const Unit&) const {}
};
struct InProjOrder : StaticOrder {
    int nMn, nwide;
    __host__ __device__ void init2(int M, int Nw, int Mn, int G_, int c_) { init(M, Nw, G_, c_); nwide = nwg; nMn = Mn / BM; }
    __host__ __device__ bool next(int i, Unit& u) const { const long L = (long)i * G + c; if (L < nwide) return StaticOrder::next(i, u); if (L >= nwide + nMn) return false; u.pm = (int)(L - nwide); u.pn = nN; u.koff = 0; u.part = 0; u.nt = 0; return true; }
};
struct HotOrder : StaticOrder {
    __host__ __device__ bool next(int i, Unit& u) const { if (!StaticOrder::next(i, u)) return false; u.pm = c & 3; u.pn = (c >> 2) & 3; return true; }
};
struct SegOrder : StaticOrder {
    __host__ __device__ bool next(int i, Unit& u) const { const int seg = i % 3; if (!StaticOrder::next(i / 3, u)) return false; u.part = seg; u.koff = seg == 0 ? 0 : (seg == 1 ? 2048 : 3072); u.nt = seg == 0 ? 16 : 8; return true; }
};
struct PieceOrder {
    int nN, np, KS, kslice_bytes, G, c;
    __host__ __device__ void init(int M, int N, int KS_, int kslice_bytes_, int G_, int c_) { nN = N / BM; np = (M / BM) * nN * KS_; KS = KS_; kslice_bytes = kslice_bytes_; G = G_; c = c_; }
    __host__ __device__ bool next(int i, Unit& u) const { const long L = (long)i * G + c; if (L >= np) return false; const int p = (int)L, t = p / KS, ks = p % KS; u.pm = t / nN; u.pn = t % nN; u.koff = ks * kslice_bytes; u.part = ks; u.nt = 0; return true; }
    __device__ __forceinline__ void a_ready(const Unit&) const {}
    __device__ __forceinline__ void done(const Unit&) const {}
};

__device__ __forceinline__ unsigned cvt_pk_bf16(float lo, float hi) { unsigned r; asm volatile("v_cvt_pk_bf16_f32 %0, %1, %2" : "=v"(r) : "v"(lo), "v"(hi)); return r; }
__device__ __forceinline__ float bf_lo(unsigned w) { return __uint_as_float(w << 16); }
__device__ __forceinline__ float bf_hi(unsigned w) { return __uint_as_float(w & 0xffff0000u); }
__device__ __forceinline__ float fsigmoid(float x) { return __builtin_amdgcn_rcpf(1.0f + __expf(-x)); }

struct EpiBf16 {
    static constexpr bool PERM = true, AFTER_DRAIN = false;
    bf16_t* O; int ldc;
    __device__ __forceinline__ void operator()(const f32x4 (&acc)[2][2][4][2], const Unit& u, int wr, int wc, int fr, int fq) const {
        const int row0 = u.pm * BM + wr * 64 + fr, col0 = u.pn * BM + wc * 32 + 8 * fq;
#pragma unroll
        for (int ai = 0; ai < 2; ++ai)
#pragma unroll
            for (int m = 0; m < 4; ++m) { bf16_t* rowp = O + (size_t)(row0 + ai * HALF + m * 16) * ldc + col0;
#pragma unroll
                for (int bj = 0; bj < 2; ++bj) { const f32x4 v0 = acc[ai][bj][m][0], v1 = acc[ai][bj][m][1];
                    u32x4 w; w.x = cvt_pk_bf16(v0[0], v0[1]); w.y = cvt_pk_bf16(v0[2], v0[3]); w.z = cvt_pk_bf16(v1[0], v1[1]); w.w = cvt_pk_bf16(v1[2], v1[3]);
                    *(u32x4*)(rowp + bj * HALF) = w; } }
    }
};
struct EpiSwiGLU {
    static constexpr bool PERM = true, AFTER_DRAIN = false;
    bf16_t* O; int ldc;
    __device__ __forceinline__ void operator()(const f32x4 (&acc)[2][2][4][2], const Unit& u, int wr, int wc, int fr, int fq) const {
        const int row0 = u.pm * BM + wr * 64 + fr, col0 = u.pn * HALF + wc * 32 + 8 * fq;
#pragma unroll
        for (int ai = 0; ai < 2; ++ai)
#pragma unroll
            for (int m = 0; m < 4; ++m) { bf16_t* rowp = O + (size_t)(row0 + ai * HALF + m * 16) * ldc + col0;
                float o[8];
#pragma unroll
                for (int n = 0; n < 2; ++n)
#pragma unroll
                    for (int j = 0; j < 4; ++j) { const float a = acc[ai][0][m][n][j], g = acc[ai][1][m][n][j]; o[n * 4 + j] = a * g * fsigmoid(g); }
                u32x4 w; w.x = cvt_pk_bf16(o[0], o[1]); w.y = cvt_pk_bf16(o[2], o[3]); w.z = cvt_pk_bf16(o[4], o[5]); w.w = cvt_pk_bf16(o[6], o[7]);
                *(u32x4*)rowp = w; }
    }
};
struct EpiF32Part {
    static constexpr bool PERM = true, AFTER_DRAIN = false;
    float* C; int ldc; size_t part_stride;
    __device__ __forceinline__ void operator()(const f32x4 (&acc)[2][2][4][2], const Unit& u, int wr, int wc, int fr, int fq) const {
        const int row0 = u.pm * BM + wr * 64 + fr, col0 = u.pn * BM + wc * 32 + 8 * fq; float* base = C + (size_t)u.part * part_stride;
#pragma unroll
        for (int ai = 0; ai < 2; ++ai)
#pragma unroll
            for (int m = 0; m < 4; ++m) { float* rowp = base + (size_t)(row0 + ai * HALF + m * 16) * ldc + col0;
#pragma unroll
                for (int bj = 0; bj < 2; ++bj) { *(f32x4*)(rowp + bj * HALF) = acc[ai][bj][m][0]; *(f32x4*)(rowp + bj * HALF + 4) = acc[ai][bj][m][1]; } }
    }
};
struct EpiNull {
    static constexpr bool PERM = true, AFTER_DRAIN = false;
    int dummy;
    __device__ __forceinline__ void operator()(const f32x4 (&acc)[2][2][4][2], const Unit&, int, int, int, int) const {
#pragma unroll
        for (int ai = 0; ai < 2; ++ai)
#pragma unroll
            for (int m = 0; m < 4; ++m)
#pragma unroll
                for (int bj = 0; bj < 2; ++bj) { asm volatile("" :: "v"(acc[ai][bj][m][0]), "v"(acc[ai][bj][m][1])); }
    }
};
struct EpiInProj {
    static constexpr bool PERM = true, AFTER_DRAIN = false;
    bf16_t* P; int ldp; float* PN; int nwide_tiles;
    __device__ __forceinline__ void operator()(const f32x4 (&acc)[2][2][4][2], const Unit& u, int wr, int wc, int fr, int fq) const {
        const int row0 = u.pm * BM + wr * 64 + fr;
        if (u.pn < nwide_tiles) {
            const int col0 = u.pn * BM + wc * 32 + 8 * fq;
#pragma unroll
            for (int ai = 0; ai < 2; ++ai)
#pragma unroll
                for (int m = 0; m < 4; ++m) { bf16_t* rowp = P + (size_t)(row0 + ai * HALF + m * 16) * ldp + col0;
#pragma unroll
                    for (int bj = 0; bj < 2; ++bj) { const f32x4 v0 = acc[ai][bj][m][0], v1 = acc[ai][bj][m][1];
                        u32x4 w; w.x = cvt_pk_bf16(v0[0], v0[1]); w.y = cvt_pk_bf16(v0[2], v0[3]); w.z = cvt_pk_bf16(v1[0], v1[1]); w.w = cvt_pk_bf16(v1[2], v1[3]);
                        *(u32x4*)(rowp + bj * HALF) = w; } }
        } else {
            const int col0 = wc * 32 + 8 * fq;
#pragma unroll
            for (int ai = 0; ai < 2; ++ai)
#pragma unroll
                for (int m = 0; m < 4; ++m) { float* rowp = PN + (size_t)(row0 + ai * HALF + m * 16) * 256 + col0;
#pragma unroll
                    for (int bj = 0; bj < 2; ++bj) { *(f32x4*)(rowp + bj * HALF) = acc[ai][bj][m][0]; *(f32x4*)(rowp + bj * HALF + 4) = acc[ai][bj][m][1]; } }
        }
    }
};
template <int STAGE> struct EpiBranch {
    static constexpr bool PERM = true, AFTER_DRAIN = false;
    const bf16_t* G; int ldg; const float* mb; bf16_t* MACC; bf16_t* MRG; int ldc;
    __device__ __forceinline__ void operator()(const f32x4 (&acc)[2][2][4][2], const Unit& u, int wr, int wc, int fr, int fq) const {
        const int row0 = u.pm * BM + wr * 64 + fr, col0 = u.pn * BM + wc * 32 + 8 * fq;
#pragma unroll
        for (int ai = 0; ai < 2; ++ai)
#pragma unroll
            for (int m = 0; m < 4; ++m) { const size_t row = (size_t)(row0 + ai * HALF + m * 16);
#pragma unroll
                for (int bj = 0; bj < 2; ++bj) { const int col = col0 + bj * HALF;
                    const u32x4 gw = *(const u32x4*)(G + row * ldg + col); const f32x4 b0 = *(const f32x4*)(mb + col), b1 = *(const f32x4*)(mb + col + 4);
                    f32x4 g0, g1;
                    g0[0] = fsigmoid(bf_lo(gw.x) + b0[0]); g0[1] = fsigmoid(bf_hi(gw.x) + b0[1]); g0[2] = fsigmoid(bf_lo(gw.y) + b0[2]); g0[3] = fsigmoid(bf_hi(gw.y) + b0[3]);
                    g1[0] = fsigmoid(bf_lo(gw.z) + b1[0]); g1[1] = fsigmoid(bf_hi(gw.z) + b1[1]); g1[2] = fsigmoid(bf_lo(gw.w) + b1[2]); g1[3] = fsigmoid(bf_hi(gw.w) + b1[3]);
                    f32x4 v0 = g0 * acc[ai][bj][m][0], v1 = g1 * acc[ai][bj][m][1];
                    bf16_t* mp = (STAGE <= 1 ? MACC : MRG) + row * ldc + col;
                    if (STAGE >= 1) { const u32x4 pw = *(const u32x4*)(MACC + row * ldc + col);
                        v0[0] += bf_lo(pw.x); v0[1] += bf_hi(pw.x); v0[2] += bf_lo(pw.y); v0[3] += bf_hi(pw.y); v1[0] += bf_lo(pw.z); v1[1] += bf_hi(pw.z); v1[2] += bf_lo(pw.w); v1[3] += bf_hi(pw.w); }
                    u32x4 w; w.x = cvt_pk_bf16(v0[0], v0[1]); w.y = cvt_pk_bf16(v0[2], v0[3]); w.z = cvt_pk_bf16(v1[0], v1[1]); w.w = cvt_pk_bf16(v1[2], v1[3]);
                    *(u32x4*)mp = w; } }
    }
};

struct EpiBranchSeg {
    static constexpr bool PERM = true, AFTER_DRAIN = false;
    const bf16_t* G; int ldg; const float* mb; bf16_t* MACC; bf16_t* MRG; int ldc;
    __device__ __forceinline__ void operator()(const f32x4 (&acc)[2][2][4][2], const Unit& u, int wr, int wc, int fr, int fq) const {
        const int row0 = u.pm * BM + wr * 64 + fr, col0 = u.pn * BM + wc * 32 + 8 * fq; const int part = u.part;
        const bf16_t* Gp = G + part * ldc; const float* mbp = mb + part * ldc; bf16_t* outp = part == 2 ? MRG : MACC;
#pragma unroll
        for (int ai = 0; ai < 2; ++ai)
#pragma unroll
            for (int m = 0; m < 4; ++m) { const size_t row = (size_t)(row0 + ai * HALF + m * 16);
#pragma unroll
                for (int bj = 0; bj < 2; ++bj) { const int col = col0 + bj * HALF;
                    const u32x4 gw = *(const u32x4*)(Gp + row * ldg + col); const f32x4 b0 = *(const f32x4*)(mbp + col), b1 = *(const f32x4*)(mbp + col + 4);
                    f32x4 g0, g1;
                    g0[0] = fsigmoid(bf_lo(gw.x) + b0[0]); g0[1] = fsigmoid(bf_hi(gw.x) + b0[1]); g0[2] = fsigmoid(bf_lo(gw.y) + b0[2]); g0[3] = fsigmoid(bf_hi(gw.y) + b0[3]);
                    g1[0] = fsigmoid(bf_lo(gw.z) + b1[0]); g1[1] = fsigmoid(bf_hi(gw.z) + b1[1]); g1[2] = fsigmoid(bf_lo(gw.w) + b1[2]); g1[3] = fsigmoid(bf_hi(gw.w) + b1[3]);
                    f32x4 v0 = g0 * acc[ai][bj][m][0], v1 = g1 * acc[ai][bj][m][1];
                    if (part >= 1) { const u32x4 pw = *(const u32x4*)(MACC + row * ldc + col);
                        v0[0] += bf_lo(pw.x); v0[1] += bf_hi(pw.x); v0[2] += bf_lo(pw.y); v0[3] += bf_hi(pw.y); v1[0] += bf_lo(pw.z); v1[1] += bf_hi(pw.z); v1[2] += bf_lo(pw.w); v1[3] += bf_hi(pw.w); }
                    u32x4 w; w.x = cvt_pk_bf16(v0[0], v0[1]); w.y = cvt_pk_bf16(v0[2], v0[3]); w.z = cvt_pk_bf16(v1[0], v1[1]); w.w = cvt_pk_bf16(v1[2], v1[3]);
                    *(u32x4*)(outp + row * ldc + col) = w; } }
    }
};

template <class Epi, class Sched, bool ALIGN_EPI = false, bool SP2 = false>
__device__ __forceinline__ void gemm_phase(PG8_LAS unsigned char* lds, const Gemm g, const Sched& S, const Epi& E) {
    int tid_ = threadIdx.x; asm volatile("" : "+v"(tid_));
    const int tid = tid_, wid = __builtin_amdgcn_readfirstlane(tid >> 6), lane = tid & 63, wr = wid >> 2, wc = wid & 3, fr = lane & 15, fq = lane >> 4;
    const int K = g.K, nt_def = K / BK;
    unsigned voffA[2], voffB[2];
#pragma unroll
    for (int i = 0; i < 2; ++i) { int R, C; stage_rc(tid * 16 + i * 8192, R, C); const int Rb = Epi::PERM ? ((R & ~31) + perm32(R & 31)) : R;
        voffA[i] = (unsigned)(R * g.lda + C) * 2u; voffB[i] = (unsigned)(Rb * g.ldb + C) * 2u; }
    const size_t kstep = (size_t)(BK * 2);
    const size_t hstepA = (size_t)HALF * g.lda * 2, hstepB = (size_t)HALF * g.ldb * 2;
    const size_t tstepA = 2 * hstepA, tstepB = 2 * hstepB;
    const unsigned ldsw = (unsigned)wid * 1024u;
    const int aoff = lds_byte(wr * 64 + fr, fq * 8), boff = lds_byte(wc * 32 + fr, fq * 8);
#define PG8_SA(b, h) (((b) * 2 + (h)) * HTB)
#define PG8_SB(b, h) ((4 + (b) * 2 + (h)) * HTB)
#define PG8_STAGE(bufoff, gbase, voff) do { _Pragma("unroll") for (int _i = 0; _i < 2; ++_i) \
        __builtin_amdgcn_global_load_lds((const unsigned*)((const char*)(gbase) + (voff)[_i]), (PG8_LAS unsigned*)(lds + (bufoff) + ldsw + _i * 8192), 16, 0, 0); } while (0)
#define PG8_LDA(dst, b, h) do { _Pragma("unroll") for (int m = 0; m < 4; ++m) _Pragma("unroll") for (int k = 0; k < 2; ++k) dst[m][k] = *(const PG8_LAS bf16x8*)(lds + PG8_SA(b, h) + aoff + m * 2048 + k * 1024); } while (0)
#define PG8_LDB(dst, b, h) do { _Pragma("unroll") for (int n = 0; n < 2; ++n) _Pragma("unroll") for (int k = 0; k < 2; ++k) dst[n][k] = *(const PG8_LAS bf16x8*)(lds + PG8_SB(b, h) + boff + n * 2048 + k * 1024); } while (0)
#define PG8_MMA(ai, bj, At, Bt) do { __builtin_amdgcn_s_setprio(1); _Pragma("unroll") for (int m = 0; m < 4; ++m) _Pragma("unroll") for (int n = 0; n < 2; ++n) _Pragma("unroll") for (int k = 0; k < 2; ++k) \
        acc[ai][bj][m][n] = __builtin_amdgcn_mfma_f32_16x16x32_bf16(Bt[n][k], At[m][k], acc[ai][bj][m][n], 0, 0, 0); __builtin_amdgcn_s_setprio(0); } while (0)
#define PG8_WAIT_V(n) asm volatile("s_waitcnt vmcnt(" #n ")" ::: "memory")
#define PG8_WAIT_L(n) asm volatile("s_waitcnt lgkmcnt(" #n ")" ::: "memory")
#define PG8_BAR __builtin_amdgcn_s_barrier()
#define PG8_SCHED __builtin_amdgcn_sched_barrier(0)
    Unit cur, nxt; int ui = 0;
    if (!S.next(0, cur)) return;
    f32x4 acc[2][2][4][2];
#pragma unroll
    for (int a = 0; a < 2; ++a)
#pragma unroll
        for (int b = 0; b < 2; ++b)
#pragma unroll
            for (int m = 0; m < 4; ++m)
#pragma unroll
                for (int n = 0; n < 2; ++n) acc[a][b][m][n] = (f32x4){0.f, 0.f, 0.f, 0.f};
    bf16x8 At[4][2], B0[2][2], B1[2][2];
    const char* cA = (const char*)g.A + (size_t)cur.pm * tstepA + cur.koff; const char* cB = (const char*)g.Bt + (size_t)cur.pn * tstepB + cur.koff;
    S.a_ready(cur);
    if constexpr (SP2) {
        PG8_STAGE(PG8_SB(0, 0), cB, voffB); PG8_STAGE(PG8_SB(0, 1), cB + hstepB, voffB); PG8_STAGE(PG8_SA(0, 0), cA, voffA); PG8_STAGE(PG8_SA(0, 1), cA + hstepA, voffA);
        if (wr == 1) PG8_BAR;
        PG8_WAIT_V(2); PG8_BAR;
        PG8_STAGE(PG8_SB(1, 0), cB + kstep, voffB); PG8_STAGE(PG8_SA(1, 0), cA + kstep, voffA); PG8_STAGE(PG8_SB(1, 1), cB + hstepB + kstep, voffB);
        PG8_WAIT_V(6); PG8_BAR;
    } else {
        PG8_STAGE(PG8_SB(0, 0), cB, voffB); PG8_STAGE(PG8_SA(0, 0), cA, voffA); PG8_STAGE(PG8_SB(0, 1), cB + hstepB, voffB); PG8_STAGE(PG8_SA(0, 1), cA + hstepA, voffA);
        if (wr == 1) PG8_BAR;
        PG8_WAIT_V(4); PG8_BAR;
        PG8_STAGE(PG8_SB(1, 0), cB + kstep, voffB); PG8_STAGE(PG8_SA(1, 0), cA + kstep, voffA); PG8_STAGE(PG8_SB(1, 1), cB + hstepB + kstep, voffB);
        PG8_WAIT_V(6); PG8_BAR;
    }
    for (;;) {
        const bool has_next = S.next(ui + 1, nxt);
        const char* nA = has_next ? (const char*)g.A + (size_t)nxt.pm * tstepA + nxt.koff : cA; const char* nB = has_next ? (const char*)g.Bt + (size_t)nxt.pn * tstepB + nxt.koff : cB;
        const int nt = cur.nt ? cur.nt : nt_def;
        asm volatile(".p2align 8" ::: "memory");
        for (int t = 0; t < nt; t += 2) {
            const bool last = (t == nt - 2);
            const char* a1 = cA + (size_t)(t + 1) * kstep;
            const char* a2 = last ? nA : cA + (size_t)(t + 2) * kstep; const char* b2 = last ? nB : cB + (size_t)(t + 2) * kstep;
            const char* a3 = a2 + kstep; const char* b3 = b2 + kstep;
            if (last && has_next) S.a_ready(nxt);
            if constexpr (SP2) {
            PG8_LDB(B0, 0, 0); PG8_LDB(B1, 0, 1); PG8_SCHED; PG8_LDA(At, 0, 0); PG8_STAGE(PG8_SA(1, 1), a1 + hstepA, voffA);
            PG8_WAIT_V(8); PG8_WAIT_L(0); PG8_BAR; PG8_MMA(0, 0, At, B0); PG8_MMA(0, 1, At, B1); PG8_BAR; PG8_SCHED;
            PG8_LDA(At, 0, 1); PG8_STAGE(PG8_SB(0, 0), b2, voffB); PG8_STAGE(PG8_SB(0, 1), b2 + hstepB, voffB); PG8_STAGE(PG8_SA(0, 0), a2, voffA);
            PG8_WAIT_V(8); PG8_WAIT_L(0); PG8_BAR; PG8_MMA(1, 0, At, B0); PG8_MMA(1, 1, At, B1); PG8_BAR; PG8_SCHED;
            PG8_LDB(B0, 1, 0); PG8_LDB(B1, 1, 1); PG8_SCHED; PG8_LDA(At, 1, 0); PG8_STAGE(PG8_SA(0, 1), a2 + hstepA, voffA);
            PG8_WAIT_V(8); PG8_WAIT_L(0); PG8_BAR; PG8_MMA(0, 0, At, B0); PG8_MMA(0, 1, At, B1); PG8_BAR; PG8_SCHED;
            PG8_LDA(At, 1, 1); PG8_STAGE(PG8_SB(1, 0), b3, voffB); PG8_STAGE(PG8_SB(1, 1), b3 + hstepB, voffB); PG8_STAGE(PG8_SA(1, 0), a3, voffA);
            PG8_WAIT_V(8); PG8_WAIT_L(0); PG8_BAR; PG8_MMA(1, 0, At, B0); PG8_MMA(1, 1, At, B1); PG8_BAR; PG8_SCHED;
            } else {
            PG8_LDB(B0, 0, 0); PG8_SCHED; PG8_LDA(At, 0, 0); PG8_STAGE(PG8_SA(1, 1), a1 + hstepA, voffA);
            PG8_WAIT_L(8); PG8_BAR; PG8_WAIT_L(0); PG8_MMA(0, 0, At, B0); PG8_BAR; PG8_SCHED;
            PG8_LDB(B1, 0, 1); PG8_STAGE(PG8_SB(0, 0), b2, voffB);
            PG8_BAR; PG8_WAIT_L(0); PG8_MMA(0, 1, At, B1); PG8_BAR;
            PG8_LDA(At, 0, 1); PG8_STAGE(PG8_SA(0, 0), a2, voffA);
            PG8_BAR; PG8_WAIT_L(0); PG8_MMA(1, 0, At, B0); PG8_BAR; PG8_SCHED;
            PG8_STAGE(PG8_SB(0, 1), b2 + hstepB, voffB);
            PG8_WAIT_V(6); PG8_BAR; PG8_MMA(1, 1, At, B1); PG8_BAR;
            PG8_LDB(B0, 1, 0); PG8_SCHED; PG8_LDA(At, 1, 0); PG8_STAGE(PG8_SA(0, 1), a2 + hstepA, voffA);
            PG8_WAIT_L(8); PG8_BAR; PG8_WAIT_L(0); PG8_MMA(0, 0, At, B0); PG8_BAR; PG8_SCHED;
            PG8_LDB(B1, 1, 1); PG8_STAGE(PG8_SB(1, 0), b3, voffB);
            PG8_BAR; PG8_WAIT_L(0); PG8_MMA(0, 1, At, B1); PG8_BAR;
            PG8_LDA(At, 1, 1); PG8_STAGE(PG8_SA(1, 0), a3, voffA);
            PG8_BAR; PG8_WAIT_L(0); PG8_MMA(1, 0, At, B0); PG8_BAR; PG8_SCHED;
            PG8_STAGE(PG8_SB(1, 1), b3 + hstepB, voffB);
            PG8_WAIT_V(6); PG8_BAR; PG8_MMA(1, 1, At, B1); PG8_BAR;
            }
        }
        if constexpr (ALIGN_EPI) { if (wr == 0) PG8_BAR; }
        if constexpr (!Epi::AFTER_DRAIN) { E(acc, cur, wr, wc, fr, fq); S.done(cur); }
        if (!has_next) break;
#pragma unroll
        for (int a = 0; a < 2; ++a)
#pragma unroll
            for (int b = 0; b < 2; ++b)
#pragma unroll
                for (int m = 0; m < 4; ++m)
#pragma unroll
                    for (int n = 0; n < 2; ++n) acc[a][b][m][n] = (f32x4){0.f, 0.f, 0.f, 0.f};
        cur = nxt; cA = nA; cB = nB; ++ui;
        if constexpr (ALIGN_EPI) { if (wr == 1) PG8_BAR; }
    }
    PG8_WAIT_V(0);
    if constexpr (!ALIGN_EPI) { if (wr == 0) PG8_BAR; }
    PG8_BAR;
#undef PG8_SA
#undef PG8_SB
#undef PG8_STAGE
#undef PG8_LDA
#undef PG8_LDB
#undef PG8_MMA
#undef PG8_WAIT_V
#undef PG8_WAIT_L
#undef PG8_BAR
#undef PG8_SCHED
}
}

#define PG8_SP2 true
#define PG8_ALIGN true

constexpr int NWAVES = 8;
constexpr int D = 2048, NB = 4, SEQ = 4096, CTXL = 256, DEPTH = 2;
constexpr int ML = NB * SEQ, MC = NB * CTXL, M = ML + MC;
constexpr int DFF = 5632, NFF = 2 * DFF, NMOD = 9 * D;
constexpr int NSRC = 12368, NWIDE = 12288, NIN = 12544;
constexpr int CVW = 2560;
constexpr float EPS = 1e-5f, ALPHA = 1.4142135623730951f;
constexpr int PC_Z = 0, PC_XBC = 1024, PC_MQ = 2560, PC_MV = 3584, PC_MO = 4096, PC_GQ = 4608, PC_GK = 4864, PC_GV = 5120, PC_GR = 5632, PC_GATE = 6144;

constexpr size_t MiB = 1u << 20;
constexpr size_t WS_CTL = 0, CTL_ZERO_BYTES = 1 * MiB;
constexpr size_t WS_MOD = 1 * MiB;
constexpr size_t WS_WB = 2 * MiB;
constexpr size_t WB_FIN = 0, WB_FOUT = WB_FIN + 2 * (size_t)NFF * D * 2, WB_WIN = WB_FOUT + 2 * (size_t)D * DFF * 2, WB_BRS = WB_WIN + (size_t)NIN * D * 2,
                 WB_BRM = WB_BRS + (size_t)D * 1024 * 2, WB_BRG = WB_BRM + (size_t)D * 512 * 2, WB_OUT = WB_BRG + (size_t)D * 512 * 2, WB_END = WB_OUT + (size_t)D * D * 2;
static_assert(WB_END <= 200 * MiB, "weights region");
constexpr size_t WS_H = 202 * MiB;
constexpr size_t WS_U = 338 * MiB;
constexpr size_t WS_Y = 406 * MiB;
constexpr size_t WS_BIG = 474 * MiB;
constexpr size_t WS_PN = 882 * MiB;
constexpr size_t WS_CV = 899 * MiB;
constexpr size_t WS_DT = 984 * MiB;
constexpr size_t WS_DA = WS_DT + (size_t)M * 32 * 4;
constexpr size_t WS_MLG = 989 * MiB;
constexpr size_t WS_DEN = WS_MLG + (size_t)M * 16 * 4;
constexpr size_t WS_GD = 991 * MiB;
constexpr size_t WS_YS = 1025 * MiB;
constexpr size_t WS_YP = 1297 * MiB;
constexpr size_t WS_PNP = 1329 * MiB;
constexpr size_t WS_END = 1337 * MiB;
static_assert(WS_H + (size_t)M * D * 4 <= WS_U && WS_U + (size_t)M * D * 2 <= WS_Y && WS_Y + (size_t)M * D * 2 <= WS_BIG && WS_BIG + (size_t)M * NWIDE * 2 <= WS_PN &&
              WS_PN + (size_t)M * 256 * 4 <= WS_CV && WS_CV + (size_t)M * CVW * 2 <= WS_DT && WS_DA + (size_t)M * 32 * 4 <= WS_MLG && WS_DEN + 2 * (size_t)M * 4 * 4 <= WS_GD &&
              WS_GD + (size_t)M * 512 * 4 <= WS_YS && WS_YS + 2 * (size_t)M * D * 4 <= WS_YP && WS_YP + 4 * (size_t)MC * D * 4 <= WS_PNP && WS_PNP + 8 * (size_t)MC * 256 * 4 <= WS_END, "d_ws map");
constexpr int CW_BAR = 4096;

constexpr int RING_OFF = 0, RING_BYTES = 131072;
constexpr int LDSCTL_OFF = RING_BYTES, MISC_OFF = LDSCTL_OFF + 320;
constexpr int LDS_BYTES = 147456;

#define GAS __attribute__((address_space(1)))
#define LAS __attribute__((address_space(3)))
typedef unsigned short bf16;
typedef unsigned v4u __attribute__((ext_vector_type(4)));
typedef unsigned v2u __attribute__((ext_vector_type(2)));
typedef float f32x4 __attribute__((ext_vector_type(4)));
#define LDS_WAIT() asm volatile("s_waitcnt lgkmcnt(0)" ::: "memory")
#define VM_WAIT() asm volatile("s_waitcnt vmcnt(0)" ::: "memory")
__device__ __forceinline__ unsigned f2bf(float f) { unsigned u = __builtin_bit_cast(unsigned, f); return (u + 0x7fffu + ((u >> 16) & 1u)) >> 16; }
__device__ __forceinline__ unsigned pk2(float lo, float hi) { unsigned r; asm("v_cvt_pk_bf16_f32 %0, %1, %2" : "=v"(r) : "v"(lo), "v"(hi)); return r; }
__device__ __forceinline__ float bflo(unsigned w) { return __uint_as_float(w << 16); }
__device__ __forceinline__ float bfhi(unsigned w) { return __uint_as_float(w & 0xffff0000u); }
__device__ __forceinline__ float silu_f(float x) { return x / (1.0f + __expf(-x)); }
__device__ __forceinline__ float sigm_f(float x) { return 1.0f / (1.0f + __expf(-x)); }
__device__ __forceinline__ float softplus_f(float x) { return fmaxf(x, 0.f) + log1pf(__expf(-fabsf(x))); }

#define XB_TMO      128
#define XB_XCNT(j)  (256  + 64 * (j))
#define XB_XSUB(j)  (1280 + 64 * (j))
#define XB_XGEN(j)  (2304 + 64 * (j))
#define XB_TOP      3328
#define XB_TOPGEN   3392
#define XCD_BAR_WORDS 3456
#define XB_SPIN_CAP (1u << 18)
__device__ __forceinline__ unsigned xb_ld(unsigned* p)              { return __hip_atomic_load(p, __ATOMIC_RELAXED, __HIP_MEMORY_SCOPE_AGENT); }
__device__ __forceinline__ unsigned xb_add(unsigned* p, unsigned v) { return __hip_atomic_fetch_add(p, v, __ATOMIC_RELAXED, __HIP_MEMORY_SCOPE_AGENT); }
__device__ __forceinline__ unsigned xb_xcc_id() { return (unsigned)__builtin_amdgcn_s_getreg((3 << 11) | 20) & 0xFu; }
#define XB_SPIN(cond, bar) do { unsigned _sp = 0; while (cond) { __builtin_amdgcn_s_sleep(1); \
    if ((++_sp & 255u) == 0u) { if (xb_ld(&(bar)[XB_TMO])) break; if (_sp > XB_SPIN_CAP) { atomicAdd(&(bar)[XB_TMO], 1u); break; } } } } while (0)
struct XcdBarrier { unsigned* bar; unsigned x; volatile LAS unsigned* st; };
__device__ __forceinline__ XcdBarrier xcd_barrier_post(unsigned* bar, volatile LAS unsigned* st) {
    XcdBarrier b; b.bar = bar; b.x = xb_xcc_id(); b.st = st;
    if (threadIdx.x == 0) (void)xb_add(&bar[XB_XCNT(b.x)], 1u);
    return b;
}
__device__ __forceinline__ void xcd_barrier_complete(unsigned* bar, unsigned x, unsigned& nloc, unsigned& nx) {
    const unsigned G = gridDim.x * gridDim.y * gridDim.z;
    unsigned sum, cnt, mine, sp = 0u;
    for (;;) {
        sum = 0u; cnt = 0u; mine = 0u;
#pragma unroll
        for (unsigned j = 0; j < 16; ++j) { const unsigned c = xb_ld(&bar[XB_XCNT(j)]); sum += c; cnt += (c > 0u) ? 1u : 0u; mine = (j == x) ? c : mine; }
        if (sum == G) break;
        __builtin_amdgcn_s_sleep(1);
        if ((++sp & 255u) == 0u) { if (xb_ld(&bar[XB_TMO])) break; if (sp > XB_SPIN_CAP) { atomicAdd(&bar[XB_TMO], 1u); break; } }
    }
    nloc = mine > 0u ? mine : 1u; nx = cnt > 0u ? cnt : 1u;
}
__device__ __forceinline__ void xcd_barrier(const XcdBarrier& b) {
    asm volatile("s_waitcnt vmcnt(0)" ::: "memory");
    __syncthreads();
    if (threadIdx.x == 0) {
        unsigned* bar = b.bar; asm volatile("" : "+s"(bar));
        __builtin_amdgcn_s_waitcnt(0);
        unsigned nloc = b.st[0], nx = b.st[1];
        if (nloc == 0u) { xcd_barrier_complete(bar, b.x, nloc, nx); b.st[0] = nloc; b.st[1] = nx; }
        const unsigned old = xb_add(&bar[XB_XSUB(b.x)], 1u);
        const unsigned gen = old / nloc;
        if (old + 1u == (gen + 1u) * nloc) {
            __builtin_amdgcn_fence(__ATOMIC_RELEASE, "agent");
            asm volatile("s_waitcnt vmcnt(0)" ::: "memory");
            const unsigned og = xb_add(&bar[XB_TOP], 1u);
            const unsigned tg = og / nx;
            if (og + 1u == (tg + 1u) * nx) xb_add(&bar[XB_TOPGEN], 1u);
            else XB_SPIN(xb_ld(&bar[XB_TOPGEN]) == tg, bar);
            __builtin_amdgcn_fence(__ATOMIC_ACQUIRE, "agent");
            xb_add(&bar[XB_XGEN(b.x)], 1u);
            asm volatile("s_waitcnt vmcnt(0)" ::: "memory");
        } else {
            XB_SPIN(xb_ld(&bar[XB_XGEN(b.x)]) == gen, bar);
            __builtin_amdgcn_fence(__ATOMIC_ACQUIRE, "agent");
            asm volatile("s_waitcnt vmcnt(0)" ::: "memory");
        }
    }
    __syncthreads();
}

struct Args { const float* in[29]; float* out; unsigned char* ws; int ph_lo, ph_hi; };
enum { I_X = 0, I_C, I_CTX, I_CCTX, I_WMOD, I_BMOD, I_LNG, I_LNB, I_FWIN, I_FWOUT, I_WIN, I_MERGEB, I_SCW, I_SCB, I_SDTB, I_SALOG, I_SD, I_SNW,
       I_MCW, I_MCB, I_MGB, I_MNW, I_GW2, I_GB2, I_GNW, I_WBS, I_WBM, I_WBG, I_WOUT };
#define CAS __attribute__((address_space(4)))
struct Frame {
    LAS unsigned char* lds;
    int tid, lane, wave, G, gw, NGW;
    const float* const CAS* in; float* out; unsigned char* ws;
};
__device__ __forceinline__ Frame mkframe(LAS unsigned char* lds) {
    Frame F; F.lds = lds;
    int t = threadIdx.x; asm volatile("" : "+v"(t));
    F.tid = t; F.lane = t & 63; F.wave = __builtin_amdgcn_readfirstlane(t >> 6);
    F.G = gridDim.x; F.gw = blockIdx.x * NWAVES + F.wave; F.NGW = F.G * NWAVES;
    const CAS Args* a = (const CAS Args*)__builtin_amdgcn_kernarg_segment_ptr(); asm volatile("" : "+s"(a));
    F.in = a->in; F.out = a->out; F.ws = a->ws;
    return F;
}
__device__ __forceinline__ float wave_sum(float v) {
#pragma unroll
    for (int o = 1; o < 64; o <<= 1) v += __shfl_xor(v, o);
    return v;
}
__device__ __forceinline__ float half_sum(float v) {
#pragma unroll
    for (int o = 1; o < 32; o <<= 1) v += __shfl_xor(v, o);
    return v;
}

struct TrItem { const float* src; bf16* dst; int ldw, ldt, ncols; };
__device__ __forceinline__ void tr_load(const TrItem& t, f32x4 (&v)[8], int lane) {
    const int n4 = 4 * (lane & 7);
#pragma unroll
    for (int i = 0; i < 8; ++i) { const int kk = 8 * i + (lane >> 3); v[i] = (n4 < t.ncols) ? *(const GAS f32x4*)(t.src + (size_t)kk * t.ldw + n4) : (f32x4){0.f, 0.f, 0.f, 0.f}; }
}
__device__ __forceinline__ void tr_store(const TrItem& t, const f32x4 (&v)[8], LAS float* scr, int lane) {
    const int n4 = 4 * (lane & 7);
#pragma unroll
    for (int i = 0; i < 8; ++i) { const int kk = 8 * i + (lane >> 3); LAS float* d = scr + kk * 33 + n4; d[0] = v[i][0]; d[1] = v[i][1]; d[2] = v[i][2]; d[3] = v[i][3]; }
    LDS_WAIT(); asm volatile("" ::: "memory");
    const int c = lane & 7;
#pragma unroll
    for (int j = 0; j < 4; ++j) { const int n = (lane >> 3) + 8 * j; const LAS float* s = scr + (8 * c) * 33 + n;
        v4u o; o.x = pk2(s[0 * 33], s[1 * 33]); o.y = pk2(s[2 * 33], s[3 * 33]); o.z = pk2(s[4 * 33], s[5 * 33]); o.w = pk2(s[6 * 33], s[7 * 33]);
        *(GAS v4u*)(t.dst + (size_t)n * t.ldt + 8 * c) = o; }
    LDS_WAIT(); asm volatile("" ::: "memory");
}
__device__ __forceinline__ TrItem tr_item_of(Frame& F, int l, int it) {
    unsigned char* wb = F.ws + WS_WB;
    constexpr int I_FI = (D / 64) * (NFF / 32), I_FO = (DFF / 64) * (D / 32), I_IN = (D / 64) * (NIN / 32), I_BS = (1024 / 64) * (D / 32), I_BM = (512 / 64) * (D / 32);
    TrItem t; int r = it;
    if (r < 2 * I_FI) { const int f = r / I_FI; r -= f * I_FI; const int kb = r / (NFF / 32), nb = r % (NFF / 32), c0 = 32 * nb;
        const int r0 = c0 < DFF ? 256 * (c0 / 128) + (c0 % 128) : 256 * ((c0 - DFF) / 128) + 128 + ((c0 - DFF) % 128);
        t.src = F.in[I_FWIN] + (size_t)(l * 2 + f) * D * NFF + (size_t)(64 * kb) * NFF + c0; t.ldw = NFF; t.ncols = 32; t.dst = (bf16*)(wb + WB_FIN) + (size_t)f * NFF * D + (size_t)r0 * D + 64 * kb; t.ldt = D; return t; }
    r -= 2 * I_FI;
    if (r < 2 * I_FO) { const int f = r / I_FO; r -= f * I_FO; const int kb = r / (D / 32), nb = r % (D / 32);
        t.src = F.in[I_FWOUT] + (size_t)(l * 2 + f) * DFF * D + (size_t)(64 * kb) * D + 32 * nb; t.ldw = D; t.ncols = 32; t.dst = (bf16*)(wb + WB_FOUT) + (size_t)f * D * DFF + (size_t)(32 * nb) * DFF + 64 * kb; t.ldt = DFF; return t; }
    r -= 2 * I_FO;
    if (r < I_IN) { const int kb = r / (NIN / 32), db = r % (NIN / 32), r0 = 32 * db; int c0 = 0, nc = 32;
        if (r0 < 2560) c0 = r0; else if (r0 < 4608) c0 = r0 - 2560 + 2592; else if (r0 < 6144) c0 = r0 - 4608 + 4656; else if (r0 < NWIDE) c0 = r0 - 6144 + 6224;
        else if (r0 == NWIDE) c0 = 2560; else if (r0 == NWIDE + 32) c0 = 6192; else if (r0 == NWIDE + 64) { c0 = 4640; nc = 16; } else nc = 0;
        t.src = F.in[I_WIN] + (size_t)l * D * NSRC + (size_t)(64 * kb) * NSRC + c0; t.ldw = NSRC; t.ncols = nc; t.dst = (bf16*)(wb + WB_WIN) + (size_t)r0 * D + 64 * kb; t.ldt = D; return t; }
    r -= I_IN;
    if (r < I_BS) { const int kb = r / (D / 32), nb = r % (D / 32); t.src = F.in[I_WBS] + (size_t)l * 1024 * D + (size_t)(64 * kb) * D + 32 * nb; t.ldw = D; t.ncols = 32; t.dst = (bf16*)(wb + WB_BRS) + (size_t)(32 * nb) * D + 64 * kb; t.ldt = D; return t; }
    r -= I_BS;
    if (r < I_BM) { const int kb = r / (D / 32), nb = r % (D / 32); t.src = F.in[I_WBM] + (size_t)l * 512 * D + (size_t)(64 * kb) * D + 32 * nb; t.ldw = D; t.ncols = 32; t.dst = (bf16*)(wb + WB_BRS) + 1024 + (size_t)(32 * nb) * D + 64 * kb; t.ldt = D; return t; }
    r -= I_BM;
    if (r < I_BM) { const int kb = r / (D / 32), nb = r % (D / 32); t.src = F.in[I_WBG] + (size_t)l * 512 * D + (size_t)(64 * kb) * D + 32 * nb; t.ldw = D; t.ncols = 32; t.dst = (bf16*)(wb + WB_BRS) + 1536 + (size_t)(32 * nb) * D + 64 * kb; t.ldt = D; return t; }
    r -= I_BM;
    { const int kb = r / (D / 32), nb = r % (D / 32); t.src = F.in[I_WOUT] + (size_t)l * D * D + (size_t)(64 * kb) * D + 32 * nb; t.ldw = D; t.ncols = 32; t.dst = (bf16*)(wb + WB_OUT) + (size_t)(32 * nb) * D + 64 * kb; t.ldt = D; return t; }
}
__device__ __forceinline__ void convert_weights(Frame& F, int l) {
    LAS float* scr = (LAS float*)(F.lds + RING_OFF + F.wave * 16384);
    constexpr int I_FI = (D / 64) * (NFF / 32), I_FO = (DFF / 64) * (D / 32), I_IN = (D / 64) * (NIN / 32), I_BS = (1024 / 64) * (D / 32), I_BM = (512 / 64) * (D / 32), I_O = (D / 64) * (D / 32);
    constexpr int NITEMS = 2 * I_FI + 2 * I_FO + I_IN + I_BS + 2 * I_BM + I_O;
    int it = F.gw; if (it >= NITEMS) return;
    TrItem cur = tr_item_of(F, l, it); f32x4 vc[8]; tr_load(cur, vc, F.lane);
    for (;;) {
        const int nx = it + F.NGW; const bool more = nx < NITEMS;
        TrItem nxt = cur; f32x4 vn[8];
        if (more) { nxt = tr_item_of(F, l, nx); tr_load(nxt, vn, F.lane); }
        tr_store(cur, vc, scr, F.lane);
        if (!more) break;
        cur = nxt; it = nx;
#pragma unroll
        for (int i = 0; i < 8; ++i) vc[i] = vn[i];
    }
}
__device__ __forceinline__ void mod_phase(Frame& F) {
    LAS float* ss = (LAS float*)(F.lds + RING_OFF);
    LAS float* red = (LAS float*)(F.lds + RING_OFF + 40960);
    float* MOD = (float*)(F.ws + WS_MOD);
    __syncthreads();
    for (int i = F.tid; i < 5 * D; i += NWAVES * 64) { const int b = i / D, k = i % D; const float v = b < NB ? F.in[I_C][b * D + k] : F.in[I_CCTX][k]; ss[i] = silu_f(v); }
    __syncthreads();
    const int half = F.lane >> 5, cl = F.lane & 31;
    for (int unit = blockIdx.x; unit < 2 * (NMOD / 128); unit += F.G) {
        const int l = unit / (NMOD / 128), col0 = (unit % (NMOD / 128)) * 128;
        const float* wp = F.in[I_WMOD] + (size_t)l * D * NMOD + col0 + 4 * cl;
        f32x4 a0 = {0.f, 0.f, 0.f, 0.f}, a1 = a0, a2 = a0, a3 = a0, a4 = a0;
#pragma unroll 8
        for (int i = 0; i < 128; ++i) { const int k = 256 * F.wave + 2 * i + half; const f32x4 wv = *(const GAS f32x4*)(wp + (size_t)k * NMOD);
            a0 += ss[k] * wv; a1 += ss[D + k] * wv; a2 += ss[2 * D + k] * wv; a3 += ss[3 * D + k] * wv; a4 += ss[4 * D + k] * wv; }
#pragma unroll
        for (int j = 0; j < 4; ++j) { a0[j] += __shfl_xor(a0[j], 32); a1[j] += __shfl_xor(a1[j], 32); a2[j] += __shfl_xor(a2[j], 32); a3[j] += __shfl_xor(a3[j], 32); a4[j] += __shfl_xor(a4[j], 32); }
        if (F.lane < 32) { LAS f32x4* rp = (LAS f32x4*)(red + F.wave * 640) + cl; rp[0] = a0; rp[32] = a1; rp[64] = a2; rp[96] = a3; rp[128] = a4; }
        __syncthreads();
        for (int o = F.tid; o < 640; o += NWAVES * 64) { const int b = o / 128, cc = o % 128; float s = F.in[I_BMOD][l * NMOD + col0 + cc];
#pragma unroll
            for (int w = 0; w < 8; ++w) s += red[w * 640 + o];
            MOD[(size_t)(l * 5 + b) * NMOD + col0 + cc] = s; }
        __syncthreads();
    }
}
__device__ __forceinline__ void modulate_rows(Frame& F, int l, int k, int rows) {
    const float* MOD = (const float*)(F.ws + WS_MOD); bf16* U = (bf16*)(F.ws + WS_U);
    for (int rr = F.gw; rr < rows; rr += 2 * F.NGW) {
        f32x4 u[2][8];
#pragma unroll
        for (int q = 0; q < 2; ++q) { const int r0 = rr + q * F.NGW, r = r0 < rows ? r0 : rr; const int b = r < ML ? r / SEQ : NB;
            const float* hp = r < ML ? F.in[I_X] + (size_t)r * D : F.in[I_CTX] + (size_t)(r - ML) * D;
            const float* mA = MOD + (size_t)(l * 5 + b) * NMOD + (3 * k + 1) * D; const float* mB = MOD + (size_t)(l * 5 + b) * NMOD + (3 * k) * D;
#pragma unroll
            for (int j = 0; j < 8; ++j) { const int c = 4 * F.lane + 256 * j; const f32x4 h = *(const GAS f32x4*)(hp + c), a = *(const GAS f32x4*)(mA + c), bb = *(const GAS f32x4*)(mB + c); u[q][j] = h * (1.0f + a) + bb; } }
#pragma unroll
        for (int q = 0; q < 2; ++q) { const int r = rr + q * F.NGW; if (r >= rows) continue;
#pragma unroll
            for (int j = 0; j < 8; ++j) { const int c = 4 * F.lane + 256 * j; v2u w; w.x = pk2(u[q][j][0], u[q][j][1]); w.y = pk2(u[q][j][2], u[q][j][3]); *(GAS v2u*)(U + (size_t)r * D + c) = w; } }
    }
}
#ifndef LN_NR
#define LN_NR 2
#endif
struct LnArgs { int l, k, ln_idx, lnx, kn; float gate_scale; bool hin_input, write_u, final_out, dummy; };
template <int NR, bool PARTS> __device__ __forceinline__ void ln_span(Frame& F, const LnArgs a, int rlo, int rhi) {
    const float* YP = (const float*)(F.ws + WS_YP);
    const float* MOD = (const float*)(F.ws + WS_MOD); bf16* U = (bf16*)(F.ws + (a.dummy ? WS_YS + 136 * MiB : WS_U)); const bf16* Y = (const bf16*)(F.ws + WS_Y); const float* H = (const float*)(F.ws + WS_H); float* HO = (float*)(F.ws + (a.dummy ? WS_YS : WS_H));
    const float* lg = F.in[I_LNG] + (size_t)(a.l * 3 + a.ln_idx) * D; const float* lb = F.in[I_LNB] + (size_t)(a.l * 3 + a.ln_idx) * D;
    const int nrow = rhi - rlo, rpw = (nrow + F.NGW - 1) / F.NGW, wlo = rlo + F.gw * rpw, whi = (wlo + rpw < rhi) ? wlo + rpw : rhi;
    if (wlo >= rhi) return;
    const int b = wlo < ML ? wlo / SEQ : NB;
    f32x4 gt[8];
    { const float* mg = MOD + (size_t)(a.l * 5 + b) * NMOD + (3 * a.k + 2) * D;
#pragma unroll
      for (int j = 0; j < 8; ++j) gt[j] = a.gate_scale * *(const GAS f32x4*)(mg + 4 * F.lane + 256 * j); }
    const float* mA = MOD + (size_t)(a.lnx * 5 + b) * NMOD + (3 * a.kn + 1) * D; const float* mB = MOD + (size_t)(a.lnx * 5 + b) * NMOD + (3 * a.kn) * D;
    for (int rr = wlo; rr < whi; rr += NR) {
        f32x4 t[NR][8]; float s[NR];
#pragma unroll
        for (int q = 0; q < NR; ++q) { s[q] = 0.f; const int r = rr + q, rc = r < whi ? r : rr;
            const float* hp = a.hin_input ? (rc < ML ? F.in[I_X] + (size_t)rc * D : F.in[I_CTX] + (size_t)(rc - ML) * D) : H + (size_t)rc * D;
#pragma unroll
            for (int j = 0; j < 8; ++j) { const int c = 4 * F.lane + 256 * j; const f32x4 h = __builtin_nontemporal_load((const GAS f32x4*)(hp + c));
                f32x4 y;
                if (PARTS) { const float* yp = YP + (size_t)(rc - ML) * D + c; y = (*(const GAS f32x4*)yp + *(const GAS f32x4*)(yp + (size_t)MC * D)) + (*(const GAS f32x4*)(yp + 2 * (size_t)MC * D) + *(const GAS f32x4*)(yp + 3 * (size_t)MC * D)); }
                else { const v2u yw = __builtin_nontemporal_load((const GAS v2u*)(Y + (size_t)rc * D + c)); y[0] = bflo(yw.x); y[1] = bfhi(yw.x); y[2] = bflo(yw.y); y[3] = bfhi(yw.y); }
                t[q][j] = ALPHA * h + gt[j] * y; s[q] += (t[q][j][0] + t[q][j][1]) + (t[q][j][2] + t[q][j][3]); } }
#pragma unroll
        for (int q = 0; q < NR; ++q) { const int r = rr + q; if (r >= whi) continue;
            const float mean = wave_sum(s[q]) * (1.f / D); float s2 = 0.f;
#pragma unroll
            for (int j = 0; j < 8; ++j) { t[q][j] = t[q][j] - mean; s2 += (t[q][j][0] * t[q][j][0] + t[q][j][1] * t[q][j][1]) + (t[q][j][2] * t[q][j][2] + t[q][j][3] * t[q][j][3]); }
            const float rstd = 1.f / sqrtf(wave_sum(s2) * (1.f / D) + EPS);
#pragma unroll
            for (int j = 0; j < 8; ++j) { const int c = 4 * F.lane + 256 * j; const f32x4 g = *(const GAS f32x4*)(lg + c), be = *(const GAS f32x4*)(lb + c);
                const f32x4 o = t[q][j] * rstd * g + be;
                if (a.final_out && !a.dummy) { if (r < ML) *(GAS f32x4*)(F.out + (size_t)r * D + c) = o; }
                else __builtin_nontemporal_store(o, (GAS f32x4*)(HO + (size_t)r * D + c));
                if (a.write_u) { const f32x4 av = *(const GAS f32x4*)(mA + c), bb = *(const GAS f32x4*)(mB + c); const f32x4 u = o * (1.0f + av) + bb;
                    v2u w; w.x = pk2(u[0], u[1]); w.y = pk2(u[2], u[3]); *(GAS v2u*)(U + (size_t)r * D + c) = w; } } }
    }
}
__device__ __forceinline__ void ln_rows(Frame& F, int l, int k, float gate_scale, bool hin_input, int ln_idx, int lnx, int kn, bool write_u, bool final_out, int rows, bool dummy = false, bool ctx_parts = false) {
    const LnArgs a{l, k, ln_idx, lnx, kn, gate_scale, hin_input, write_u, final_out, dummy};
    ln_span<LN_NR, false>(F, a, 0, rows < ML ? rows : ML);
    if (rows > ML) { if (ctx_parts) ln_span<1, true>(F, a, ML, rows); else ln_span<1, false>(F, a, ML, rows); }
}
__device__ __forceinline__ void prep_phase(Frame& F, int l, int mode = 3) {
    const bf16* P = (const bf16*)(F.ws + WS_BIG); bf16* CV = (bf16*)(F.ws + WS_CV); const float* PN = (const float*)(F.ws + WS_PN);
    const int gt = blockIdx.x * (NWAVES * 64) + F.tid, NT = F.G * NWAVES * 64;
    if (mode & 1) {
        constexpr int NCG = CVW / 8;
        const int nx = (F.G % 8 == 0) ? 8 : 1, wpx = F.G / nx, xcd = (int)blockIdx.x % nx, wix = (int)blockIdx.x / nx;
        const int RS = (wpx * NWAVES * 64) / NCG;
        const int lt = wix * (NWAVES * 64) + F.tid, cg = lt % NCG, ch0 = cg * 8;
        const int rows_x = (M + nx - 1) / nx, rlo = xcd * rows_x, rhi = (rlo + rows_x < M) ? rlo + rows_x : M;
        const int rbeg = rlo + lt / NCG;
        if (lt / NCG < RS) {
            const float* w9; const float* bs; int wst;
            if (ch0 < 1536) { w9 = F.in[I_SCW] + (size_t)l * 9 * 1536 + ch0; bs = F.in[I_SCB] + l * 1536 + ch0; wst = 1536; }
            else { w9 = F.in[I_MCW] + (size_t)l * 9 * 1024 + (ch0 - 1536); bs = F.in[I_MCB] + l * 1024 + (ch0 - 1536); wst = 1024; }
            f32x4 wa[9], wb[9];
#pragma unroll
            for (int t9 = 0; t9 < 9; ++t9) { wa[t9] = *(const GAS f32x4*)(w9 + t9 * wst); wb[t9] = *(const GAS f32x4*)(w9 + t9 * wst + 4); }
            const f32x4 b0 = *(const GAS f32x4*)bs, b1 = *(const GAS f32x4*)(bs + 4);
            for (int rr = rbeg; rr < rhi; rr += 2 * RS) {
                v4u xv[2][9]; bool ok[2][9];
#pragma unroll
                for (int q = 0; q < 2; ++q) { const int r0_ = rr + q * RS, r = r0_ < rhi ? r0_ : rr;
                    const bf16* pin = P + (size_t)r * NWIDE + PC_XBC + ch0;
                    if (r < ML) { const int t = r % SEQ, gr = t >> 6, gc = t & 63;
#pragma unroll
                        for (int dr = -1; dr <= 1; ++dr)
#pragma unroll
                            for (int dc = -1; dc <= 1; ++dc) { const int i9 = (dr + 1) * 3 + (dc + 1); const bool v = !(gr + dr < 0 || gr + dr > 63 || gc + dc < 0 || gc + dc > 63); ok[q][i9] = v;
                                xv[q][i9] = v ? *(const GAS v4u*)(pin + (ptrdiff_t)(dr * 64 + dc) * NWIDE) : (v4u){0u, 0u, 0u, 0u}; }
                    } else { const int t = (r - ML) % CTXL;
#pragma unroll
                        for (int i9 = 0; i9 < 9; ++i9) { const int dc = i9 % 3 - 1; const bool v = (i9 / 3 == 1) && !(t + dc < 0 || t + dc >= CTXL); ok[q][i9] = v;
                            xv[q][i9] = v ? *(const GAS v4u*)(pin + (ptrdiff_t)dc * NWIDE) : (v4u){0u, 0u, 0u, 0u}; } }
                }
#pragma unroll
                for (int q = 0; q < 2; ++q) { const int r = rr + q * RS; if (r >= rhi) continue;
                    f32x4 a0 = b0, a1 = b1;
#pragma unroll
                    for (int i9 = 0; i9 < 9; ++i9) { const v4u x = xv[q][i9]; const f32x4 w0 = wa[i9], w1 = wb[i9];
                        a0[0] += bflo(x.x) * w0[0]; a0[1] += bfhi(x.x) * w0[1]; a0[2] += bflo(x.y) * w0[2]; a0[3] += bfhi(x.y) * w0[3];
                        a1[0] += bflo(x.z) * w1[0]; a1[1] += bfhi(x.z) * w1[1]; a1[2] += bflo(x.w) * w1[2]; a1[3] += bfhi(x.w) * w1[3]; }
                    v4u o; o.x = pk2(silu_f(a0[0]), silu_f(a0[1])); o.y = pk2(silu_f(a0[2]), silu_f(a0[3])); o.z = pk2(silu_f(a1[0]), silu_f(a1[1])); o.w = pk2(silu_f(a1[2]), silu_f(a1[3]));
                    *(GAS v4u*)(CV + (size_t)r * CVW + ch0) = o; }
            }
        }
    }
    float* DT = (float*)(F.ws + WS_DT); float* DA = (float*)(F.ws + WS_DA); float* MLG = (float*)(F.ws + WS_MLG); float* GD = (float*)(F.ws + WS_GD);
    if (mode & 2) {
        const int c = F.tid, d = c >> 8, j = c & 255;
        const float* w2 = F.in[I_GW2] + (size_t)(l * 2 + d) * 16 * 256 + j; const float b2 = F.in[I_GB2][(l * 2 + d) * 256 + j];
        float w2r[16];
#pragma unroll
        for (int q = 0; q < 16; ++q) w2r[q] = w2[q * 256];
        const float cb = c < 32 ? F.in[I_SDTB][l * 32 + c] : (c < 48 ? F.in[I_MGB][l * 16 + (c - 32)] : 0.f);
        const int pc = c < 32 ? c : (c < 48 ? 64 + (c - 32) : 0);
        int r = blockIdx.x;
        f32x4 n0, n1, n2, n3; float ns = 0.f;
        const float* PNP = (const float*)(F.ws + WS_PNP);
#define PN_LOAD(R) do { if ((R) < ML) { const float* pn_ = PN + (size_t)(R) * 256; n0 = *(const GAS f32x4*)(pn_ + 32 + d * 16); n1 = *(const GAS f32x4*)(pn_ + 36 + d * 16); n2 = *(const GAS f32x4*)(pn_ + 40 + d * 16); n3 = *(const GAS f32x4*)(pn_ + 44 + d * 16); ns = pn_[pc]; } \
        else { n0 = n1 = n2 = n3 = (f32x4){0.f, 0.f, 0.f, 0.f}; ns = 0.f; _Pragma("unroll") for (int ks_ = 0; ks_ < 8; ++ks_) { const float* pn_ = PNP + ((size_t)ks_ * MC + ((R) - ML)) * 256; \
            n0 += *(const GAS f32x4*)(pn_ + 32 + d * 16); n1 += *(const GAS f32x4*)(pn_ + 36 + d * 16); n2 += *(const GAS f32x4*)(pn_ + 40 + d * 16); n3 += *(const GAS f32x4*)(pn_ + 44 + d * 16); ns += pn_[pc]; } } } while (0)
        if (r < M) PN_LOAD(r);
        for (; r < M; r += F.G) {
            const f32x4 l0 = n0, l1 = n1, l2 = n2, l3 = n3; const float sv = ns;
            const int rn = r + F.G;
            if (rn < M) PN_LOAD(rn);
            float z = b2;
#pragma unroll
            for (int q = 0; q < 4; ++q) { z += l0[q] * w2r[q]; z += l1[q] * w2r[4 + q]; z += l2[q] * w2r[8 + q]; z += l3[q] * w2r[12 + q]; }
            const float ls = fminf(z, 0.f) - __logf(1.0f + __expf(-fabsf(z)));
            GD[(size_t)r * 512 + c] = ls * (1.0f / 16.0f);
            if (c < 32) DT[(size_t)r * 32 + c] = softplus_f(sv + cb);
            else if (c < 48) { const int i = c - 32; const float g = sv + cb;
                MLG[(size_t)r * 16 + i] = ((i >> 2) & 1) ? (fminf(g, 0.f) - log1pf(__expf(-fabsf(g)))) : g; }
        }
    }
}
#define LBAR() do { asm volatile("s_waitcnt lgkmcnt(0)" ::: "memory"); __builtin_amdgcn_s_barrier(); asm volatile("" ::: "memory"); } while (0)
typedef float f32x16 __attribute__((ext_vector_type(16)));
typedef short bf16x8v __attribute__((ext_vector_type(8)));
__device__ __forceinline__ void unpack8(const v4u w, float (&o)[8]) { o[0] = bflo(w.x); o[1] = bfhi(w.x); o[2] = bflo(w.y); o[3] = bfhi(w.y); o[4] = bflo(w.z); o[5] = bfhi(w.z); o[6] = bflo(w.w); o[7] = bfhi(w.w); }
template <int KS> __device__ __forceinline__ void mma_tile(f32x16& acc, const LAS unsigned char* A, int sa, int rA, const LAS unsigned char* B, int sb, int rB, int r, int h) {
    const LAS unsigned char* ap = A + (rA + r) * sa + 16 * h; const LAS unsigned char* bp = B + (rB + r) * sb + 16 * h;
#pragma unroll
    for (int s0 = 0; s0 < KS; s0 += 4) {
        bf16x8v a[4], b[4];
#pragma unroll
        for (int s = 0; s < 4; ++s) if (s0 + s < KS) { a[s] = *(const LAS bf16x8v*)(ap + 32 * (s0 + s)); b[s] = *(const LAS bf16x8v*)(bp + 32 * (s0 + s)); }
        __builtin_amdgcn_sched_barrier(0);
#pragma unroll
        for (int s = 0; s < 4; ++s) if (s0 + s < KS) acc = __builtin_amdgcn_mfma_f32_32x32x16_bf16(a[s], b[s], acc, 0, 0, 0);
    }
}
__device__ __forceinline__ void store_tile_T(const f32x16& acc, LAS unsigned char* img, int stride, int row0, int k0, int r, int h) {
#pragma unroll
    for (int g = 0; g < 4; ++g) { v2u w; w.x = pk2(acc[4 * g], acc[4 * g + 1]); w.y = pk2(acc[4 * g + 2], acc[4 * g + 3]);
        *(LAS v2u*)(img + (row0 + r) * stride + (k0 + 8 * g + 4 * h) * 2) = w; }
}
__device__ __forceinline__ float wave_incl_scan(float v, int lane) {
#pragma unroll
    for (int o = 1; o < 64; o <<= 1) { const float t = __shfl_up(v, o); if (lane >= o) v += t; }
    return v;
}
__device__ __forceinline__ float half_incl_scan_dpp(float v) {
    int x = __builtin_bit_cast(int, v);
#define HS_STEP(CTRL, RM) do { const int t_ = __builtin_amdgcn_update_dpp(0, x, (CTRL), (RM), 0xf, false); x = __builtin_bit_cast(int, __builtin_bit_cast(float, x) + __builtin_bit_cast(float, t_)); } while (0)
    HS_STEP(0x111, 0xf); HS_STEP(0x112, 0xf); HS_STEP(0x114, 0xf); HS_STEP(0x118, 0xf);
    HS_STEP(0x142, 0xa);
#undef HS_STEP
    return __builtin_bit_cast(float, x);
}
__device__ __forceinline__ int scan_chunk_row0(int b, int d, int c) {
    if (c < CTXL / 64) return ML + b * CTXL + 64 * (d ? CTXL / 64 - 1 - c : c);
    const int lc = c - CTXL / 64; return b * SEQ + 64 * (d ? SEQ / 64 - 1 - lc : lc);
}
template <int KIND, int DRY = 0> __device__ __forceinline__ void scan_chunked(Frame& F, int l, int task) {
    constexpr int DK = KIND == 1 ? 128 : 64, NVT = KIND == 1 ? 3 : 2, DVR = 64, NKT = DK / 32;
    constexpr int NST = NKT * NVT, NOT = 2 * NVT, ST_PW = (NST + 7) / 8, OT_PW = (NOT + 7) / 8;
    constexpr int SQ = (DK + 8) * 2, SJ = 144;
    constexpr int O_QA = 0, O_KA = O_QA + 64 * SQ, O_VT = O_KA + 64 * SQ, O_KET = O_VT + NVT * 32 * SJ, O_AIM = O_KET + DK * SJ, O_STI = O_AIM + 64 * SJ, O_TAB = O_STI + NVT * 32 * SQ;
    constexpr int TABF = 64 * 6;
    static_assert(O_TAB + 2 * TABF * 4 <= RING_BYTES, "scan LDS");
    LAS unsigned char* L = F.lds;
    int tid_ = F.tid; asm volatile("" : "+v"(tid_));
    const int tid = tid_, lane = tid & 63, w = __builtin_amdgcn_readfirstlane(tid >> 6), r = lane & 31, h = lane >> 5;
    int b, d, hd; int vh = 0;
    if (KIND == 0) { b = task >> 5; d = (task >> 4) & 1; hd = task & 15; } else { b = task >> 4; d = (task >> 3) & 1; hd = (task >> 1) & 3; vh = task & 1; }
    const bf16* CV = (const bf16*)(F.ws + WS_CV); const bf16* P = (const bf16*)(F.ws + WS_BIG);
    bf16* YS = (bf16*)(F.ws + WS_YS) + (size_t)d * M * D; float* DEN = (float*)(F.ws + WS_DEN) + (size_t)d * M * 4;
    const bf16 *qsrc, *ksrc, *vsrc; int qpitch, vpitch, ycol;
    if (KIND == 0) { qsrc = CV + 1280 + (hd >> 2) * 64; ksrc = CV + 1024 + (hd >> 2) * 64; vsrc = CV + hd * 64; qpitch = CVW; vpitch = CVW; ycol = hd * 64; }
    else if (KIND == 1) { qsrc = CV + 1536 + hd * 128; ksrc = CV + 2048 + hd * 128; vsrc = P + PC_MV + hd * 128 + vh * 64; qpitch = CVW; vpitch = NWIDE; ycol = 1024 + hd * 128 + vh * 64; }
    else { qsrc = P + PC_GQ + hd * 64; ksrc = P + PC_GK + hd * 64; vsrc = P + PC_GV + hd * 128 + vh * 64; qpitch = NWIDE; vpitch = NWIDE; ycol = 1536 + hd * 128 + vh * 64; }
    const float* sc1; float aneg = 0.f;
    if (KIND == 0) { sc1 = (const float*)(F.ws + WS_DT) + d * 16 + hd; aneg = -__expf(F.in[I_SALOG][l * 32 + d * 16 + hd]); }
    else sc1 = (const float*)(F.ws + WS_MLG) + d * 8 + hd;
    const float* gdsrc = (const float*)(F.ws + WS_GD) + d * 256 + hd * 64;
    const int pr = tid & 31, grp = tid >> 5;
    const bool isq = (DK == 128) || grp < 8;
    const int qkg = (DK == 128) ? grp : (grp & 7);
    const bool hasv = (DVR == 128) || grp < 8;
    constexpr int TW = 7;
    int sti[ST_PW], oti[OT_PW];
#pragma unroll
    for (int s = 0; s < ST_PW; ++s) { const int i = (KIND != 1) ? (w >= 4 ? w - 4 : NST) : (w + 8 * s); sti[s] = (i < NST) ? i : -1; }
#pragma unroll
    for (int s = 0; s < OT_PW; ++s) { const int i = (KIND != 1) ? (w < 4 ? w : NOT) : (w + 8 * s); oti[s] = (i < NOT) ? i : -1; }
    const int p1i = (KIND == 1) ? (w >= 4 ? w - 4 : -1) : (w < 4 ? w : -1);
    f32x16 st[ST_PW];
#pragma unroll
    for (int s = 0; s < ST_PW; ++s)
#pragma unroll
        for (int i = 0; i < 16; ++i) st[s][i] = 0.f;
    for (int i = tid; i < NVT * 32 * SQ / 4; i += NWAVES * 64) ((LAS unsigned*)(L + O_STI))[i] = 0u;
    if (KIND == 1) for (int i = tid; i < 32 * SJ / 4; i += NWAVES * 64) ((LAS unsigned*)(L + O_VT + 64 * SJ))[i] = (i < SJ / 4) ? 0x3f803f80u : 0u;
    v4u rq[2], rk[2], rv[2]; float rs1 = 0.f, rs2 = 0.f; f32x4 rg[4];
    constexpr int NCH = (CTXL + SEQ) / 64;
    f32x16 ohold[OT_PW]; int orow0 = 0;
#define SCAN_STORE_OUT() do { _Pragma("unroll") for (int s = 0; s < OT_PW; ++s) if (oti[s] >= 0) { const int tt = oti[s] & 1, vt = oti[s] >> 1; \
        _Pragma("unroll") for (int i = 0; i < 16; ++i) { const int t = 32 * tt + (i & 3) + 8 * (i >> 2) + 4 * h; \
            if (KIND == 1 && vt == 2) { if (r == 0 && vh == 0) DEN[(size_t)(orow0 + t) * 4 + hd] = ohold[s][i]; } \
            else YS[(size_t)(orow0 + t) * D + ycol + 32 * vt + r] = (bf16)f2bf(ohold[s][i]); } } } while (0)
#define SCAN_PREFETCH(ROW0) do { const size_t r0_ = (size_t)((ROW0) + 2 * pr), r1_ = r0_ + 1; \
        if (DK == 128) { rq[0] = *(const GAS v4u*)(qsrc + r0_ * qpitch + 8 * qkg); rq[1] = *(const GAS v4u*)(qsrc + r1_ * qpitch + 8 * qkg); rk[0] = *(const GAS v4u*)(ksrc + r0_ * qpitch + 8 * qkg); rk[1] = *(const GAS v4u*)(ksrc + r1_ * qpitch + 8 * qkg); } \
        else { const bf16* sp_ = isq ? qsrc : ksrc; rq[0] = *(const GAS v4u*)(sp_ + r0_ * qpitch + 8 * qkg); rq[1] = *(const GAS v4u*)(sp_ + r1_ * qpitch + 8 * qkg); } \
        if (hasv) { rv[0] = *(const GAS v4u*)(vsrc + r0_ * vpitch + 8 * grp); rv[1] = *(const GAS v4u*)(vsrc + r1_ * vpitch + 8 * grp); } \
        if (KIND != 2) { if (w == TW) { rs1 = sc1[(size_t)((ROW0) + lane) * (KIND == 0 ? 32 : 16)]; if (KIND == 1) rs2 = sc1[(size_t)((ROW0) + lane) * 16 + 4]; } } \
        else { rg[0] = *(const GAS f32x4*)(gdsrc + r0_ * 512 + 8 * qkg); rg[1] = *(const GAS f32x4*)(gdsrc + r0_ * 512 + 8 * qkg + 4); rg[2] = *(const GAS f32x4*)(gdsrc + r1_ * 512 + 8 * qkg); rg[3] = *(const GAS f32x4*)(gdsrc + r1_ * 512 + 8 * qkg + 4); } \
    } while (0)
#define SCAN_TABLES(SET) do { constexpr float L2E = 1.4426950408889634f; LAS float* T_ = (LAS float*)(L + O_TAB) + (SET) * TABF; \
        const float lg_ = (KIND == 0) ? rs1 * aneg : rs2; const float inc_ = wave_incl_scan(lg_, lane), tot_ = __shfl(inc_, 63); \
        const float cs_ = d ? (tot_ - inc_ + lg_) : inc_; const float ii_ = (KIND == 1) ? rs1 : 0.f; \
        T_[lane] = cs_ * L2E; T_[64 + lane] = (cs_ - ii_) * L2E; T_[128 + lane] = (KIND == 0) ? rs1 : 1.f; \
        T_[192 + lane] = __expf(cs_); T_[256 + lane] = __expf(tot_ - cs_ + ii_) * ((KIND == 0) ? rs1 : 1.f); if (lane == 0) T_[320] = __expf(tot_); } while (0)
    SCAN_PREFETCH(scan_chunk_row0(b, d, 0));
    if (KIND != 2 && w == TW) SCAN_TABLES(0);
    LBAR();
    for (int c = 0; c < NCH; ++c) {
        const int row0 = scan_chunk_row0(b, d, c);
        LAS float* T1 = (LAS float*)(L + O_TAB) + (KIND == 2 ? 0 : (c & 1) * TABF); LAS float* T2 = T1 + 64; LAS float* T3 = T2 + 64; LAS float* ET = T3 + 64; LAS float* EJ = ET + 64; LAS float* DEC = EJ + 64;
        if (DRY != 2) {
            const int t0 = 2 * pr, t1 = t0 + 1;
            float a0[8], a1[8];
            if (DK == 128) {
                unpack8(rq[0], a0); unpack8(rq[1], a1); const float qs = 0.08838834764831845f;
                v4u o0, o1; o0.x = pk2(a0[0] * qs, a0[1] * qs); o0.y = pk2(a0[2] * qs, a0[3] * qs); o0.z = pk2(a0[4] * qs, a0[5] * qs); o0.w = pk2(a0[6] * qs, a0[7] * qs);
                o1.x = pk2(a1[0] * qs, a1[1] * qs); o1.y = pk2(a1[2] * qs, a1[3] * qs); o1.z = pk2(a1[4] * qs, a1[5] * qs); o1.w = pk2(a1[6] * qs, a1[7] * qs);
                *(LAS v4u*)(L + O_QA + t0 * SQ + 16 * qkg) = o0; *(LAS v4u*)(L + O_QA + t1 * SQ + 16 * qkg) = o1;
                *(LAS v4u*)(L + O_KA + t0 * SQ + 16 * qkg) = rk[0]; *(LAS v4u*)(L + O_KA + t1 * SQ + 16 * qkg) = rk[1];
                unpack8(rk[0], a0); unpack8(rk[1], a1); const float e0 = EJ[t0], e1 = EJ[t1];
#pragma unroll
                for (int e = 0; e < 8; ++e) *(LAS unsigned*)(L + O_KET + (8 * qkg + e) * SJ + 4 * pr) = pk2(a0[e] * e0, a1[e] * e1);
            } else if (KIND == 0) {
                if (isq) { *(LAS v4u*)(L + O_QA + t0 * SQ + 16 * qkg) = rq[0]; *(LAS v4u*)(L + O_QA + t1 * SQ + 16 * qkg) = rq[1]; }
                else { *(LAS v4u*)(L + O_KA + t0 * SQ + 16 * qkg) = rq[0]; *(LAS v4u*)(L + O_KA + t1 * SQ + 16 * qkg) = rq[1];
                    unpack8(rq[0], a0); unpack8(rq[1], a1); const float e0 = EJ[t0], e1 = EJ[t1];
#pragma unroll
                    for (int e = 0; e < 8; ++e) *(LAS unsigned*)(L + O_KET + (8 * qkg + e) * SJ + 4 * pr) = pk2(a0[e] * e0, a1[e] * e1); }
            } else {
                float la0[8], la1[8], c0[8], c1[8], tot[8];
#pragma unroll
                for (int e = 0; e < 4; ++e) { la0[e] = rg[0][e]; la0[4 + e] = rg[1][e]; la1[e] = rg[2][e]; la1[4 + e] = rg[3][e]; }
#pragma unroll
                for (int e = 0; e < 8; ++e) { const float sp = la0[e] + la1[e]; const float inc = half_incl_scan_dpp(sp);
                    tot[e] = __shfl(inc, 31, 32);
                    if (!d) { c1[e] = inc; c0[e] = inc - la1[e]; } else { const float suf = tot[e] - inc + sp; c0[e] = suf; c1[e] = suf - la0[e]; } }
                unpack8(rq[0], a0); unpack8(rq[1], a1);
                if (isq) { float q0[8], q1[8];
#pragma unroll
                    for (int e = 0; e < 8; ++e) { q0[e] = a0[e] * 0.125f * __expf(c0[e]); q1[e] = a1[e] * 0.125f * __expf(c1[e]); }
                    v4u o0, o1; o0.x = pk2(q0[0], q0[1]); o0.y = pk2(q0[2], q0[3]); o0.z = pk2(q0[4], q0[5]); o0.w = pk2(q0[6], q0[7]); o1.x = pk2(q1[0], q1[1]); o1.y = pk2(q1[2], q1[3]); o1.z = pk2(q1[4], q1[5]); o1.w = pk2(q1[6], q1[7]);
                    *(LAS v4u*)(L + O_QA + t0 * SQ + 16 * qkg) = o0; *(LAS v4u*)(L + O_QA + t1 * SQ + 16 * qkg) = o1;
                } else { float k0[8], k1[8];
#pragma unroll
                    for (int e = 0; e < 8; ++e) { k0[e] = a0[e] * __expf(-c0[e]); k1[e] = a1[e] * __expf(-c1[e]); }
                    v4u o0, o1; o0.x = pk2(k0[0], k0[1]); o0.y = pk2(k0[2], k0[3]); o0.z = pk2(k0[4], k0[5]); o0.w = pk2(k0[6], k0[7]); o1.x = pk2(k1[0], k1[1]); o1.y = pk2(k1[2], k1[3]); o1.z = pk2(k1[4], k1[5]); o1.w = pk2(k1[6], k1[7]);
                    *(LAS v4u*)(L + O_KA + t0 * SQ + 16 * qkg) = o0; *(LAS v4u*)(L + O_KA + t1 * SQ + 16 * qkg) = o1;
#pragma unroll
                    for (int e = 0; e < 8; ++e) *(LAS unsigned*)(L + O_KET + (8 * qkg + e) * SJ + 4 * pr) = pk2(a0[e] * __expf(tot[e] - c0[e]), a1[e] * __expf(tot[e] - c1[e]));
                    if (pr == 0) {
#pragma unroll
                        for (int e = 0; e < 8; ++e) DEC[8 * qkg + e] = __expf(tot[e]); } }
            }
            if (hasv) { unpack8(rv[0], a0); unpack8(rv[1], a1);
#pragma unroll
                for (int e = 0; e < 8; ++e) *(LAS unsigned*)(L + O_VT + (8 * grp + e) * SJ + 4 * pr) = pk2(a0[e], a1[e]); }
        }
        if (DRY == 2) { asm volatile("" :: "v"(rq[0]), "v"(rq[1]), "v"(rv[0]), "v"(rv[1])); if (DK == 128) asm volatile("" :: "v"(rk[0]), "v"(rk[1])); if (KIND == 2) asm volatile("" :: "v"(rg[0]), "v"(rg[1]), "v"(rg[2]), "v"(rg[3])); }
        if (c + 1 < NCH) SCAN_PREFETCH(scan_chunk_row0(b, d, c + 1));
        if (c > 0 && DRY == 0) SCAN_STORE_OUT();
        LBAR();
#pragma unroll
        for (int s = 0; s < ST_PW; ++s) if (DRY != 1 && sti[s] >= 0) { const int kt = sti[s] % NKT, vt = sti[s] / NKT;
            if (KIND == 2) {
#pragma unroll
                for (int g = 0; g < 4; ++g) { const f32x4 dv = *(const LAS f32x4*)(DEC + 32 * kt + 8 * g + 4 * h);
#pragma unroll
                    for (int e = 0; e < 4; ++e) st[s][4 * g + e] *= dv[e]; }
            } else { const float dv = DEC[0];
#pragma unroll
                for (int i = 0; i < 16; ++i) st[s][i] *= dv; }
            mma_tile<4>(st[s], L + O_KET, SJ, 32 * kt, L + O_VT, SJ, 32 * vt, r, h); }
        if (DRY != 1 && p1i >= 0) { const int jt = p1i & 1, tt = p1i >> 1;
            f32x16 a;
#pragma unroll
            for (int i = 0; i < 16; ++i) a[i] = 0.f;
            mma_tile<DK / 16>(a, L + O_KA, SQ, 32 * jt, L + O_QA, SQ, 32 * tt, r, h);
            const int t = 32 * tt + r; const float t1v = (KIND == 2) ? 0.f : T1[t];
#pragma unroll
            for (int g = 0; g < 4; ++g) { const int jb = 32 * jt + 8 * g + 4 * h;
                f32x4 t2 = {0.f, 0.f, 0.f, 0.f}, t3 = {1.f, 1.f, 1.f, 1.f};
                if (KIND != 2) { t2 = *(const LAS f32x4*)(T2 + jb); if (KIND == 0) t3 = *(const LAS f32x4*)(T3 + jb); }
#pragma unroll
                for (int e = 0; e < 4; ++e) { const int j = jb + e; const bool keep = d ? (j >= t) : (j <= t);
                    const float wv = (KIND == 2) ? 1.f : __builtin_amdgcn_exp2f(t1v - t2[e]) * t3[e];
                    a[4 * g + e] = keep ? a[4 * g + e] * wv : 0.f; } }
            store_tile_T(a, L + O_AIM, SJ, 32 * tt, 32 * jt, r, h); }
        LBAR();
#pragma unroll
        for (int s = 0; s < OT_PW; ++s) if (DRY != 1 && oti[s] >= 0) { const int tt = oti[s] & 1, vt = oti[s] >> 1;
            f32x16 o1, o2;
#pragma unroll
            for (int i = 0; i < 16; ++i) { o1[i] = 0.f; o2[i] = 0.f; }
            mma_tile<4>(o1, L + O_AIM, SJ, 32 * tt, L + O_VT, SJ, 32 * vt, r, h);
            mma_tile<DK / 16>(o2, L + O_QA, SQ, 32 * tt, L + O_STI, SQ, 32 * vt, r, h);
#pragma unroll
            for (int g = 0; g < 4; ++g) { f32x4 ev = {1.f, 1.f, 1.f, 1.f}; if (KIND != 2) ev = *(const LAS f32x4*)(ET + 32 * tt + 8 * g + 4 * h);
#pragma unroll
                for (int e = 0; e < 4; ++e) ohold[s][4 * g + e] = o1[4 * g + e] + ev[e] * o2[4 * g + e]; } }
        orow0 = row0;
        if (KIND != 2 && w == TW && c + 1 < NCH) SCAN_TABLES((c + 1) & 1);
        LBAR();
#pragma unroll
        for (int s = 0; s < ST_PW; ++s) if (sti[s] >= 0) { const int kt = sti[s] % NKT, vt = sti[s] / NKT; store_tile_T(st[s], L + O_STI, SQ, 32 * vt, 32 * kt, r, h); }
    }
    if (DRY == 0) SCAN_STORE_OUT();
#undef SCAN_PREFETCH
#undef SCAN_STORE_OUT
#undef SCAN_TABLES
    LBAR();
}
__device__ __forceinline__ void scan_phase(Frame& F, int l) {
    for (int t = blockIdx.x; t < 256; t += F.G) {
        if (PROBE & 262144) { if (t < 128) scan_chunked<0, 1>(F, l, t); else if (t < 192) scan_chunked<1, 1>(F, l, t - 128); else scan_chunked<2, 1>(F, l, t - 192); }
        if (PROBE & 524288) { if (t < 128) scan_chunked<0, 2>(F, l, t); else if (t < 192) scan_chunked<1, 2>(F, l, t - 128); else scan_chunked<2, 2>(F, l, t - 192); }
        if (t < 128) { scan_chunked<0>(F, l, t); if (PROBE & 8192) scan_chunked<0>(F, l, t); }
        else if (t < 192) { scan_chunked<1>(F, l, t - 128); if (PROBE & 16384) scan_chunked<1>(F, l, t - 128); }
        else { scan_chunked<2>(F, l, t - 192); if (PROBE & 32768) scan_chunked<2>(F, l, t - 192); }
    }
}
__device__ __forceinline__ void finish_phase(Frame& F, int l, int rows) {
    const bf16* P = (const bf16*)(F.ws + WS_BIG); const bf16* CV = (const bf16*)(F.ws + WS_CV); const bf16* Y0 = (const bf16*)(F.ws + WS_YS); const bf16* Y1 = Y0 + (size_t)M * D; bf16* ABR = (bf16*)(F.ws + WS_U);
    const float* DEN0 = (const float*)(F.ws + WS_DEN); const float* DEN1 = DEN0 + (size_t)M * 4;
    const float* dsk = F.in[I_SD] + l * 16; const float* snw = F.in[I_SNW] + l * 1024; const float* mnw = F.in[I_MNW] + l * 512; const float* gnw = F.in[I_GNW] + l * 512;
    for (int rr = F.gw; rr < rows; rr += 2 * F.NGW) {
        v2u ya[2][8], yb[2][8], xw[2][4], gw[2][8]; float dn0[2][2], dn1[2][2];
#pragma unroll
        for (int q = 0; q < 2; ++q) { const int r0_ = rr + q * F.NGW, r = r0_ < rows ? r0_ : rr;
#pragma unroll
            for (int j = 0; j < 8; ++j) { const int c = 256 * j + 4 * F.lane; ya[q][j] = __builtin_nontemporal_load((const GAS v2u*)(Y0 + (size_t)r * D + c)); yb[q][j] = __builtin_nontemporal_load((const GAS v2u*)(Y1 + (size_t)r * D + c)); }
#pragma unroll
            for (int j = 0; j < 4; ++j) { const int c = 256 * j + 4 * F.lane; xw[q][j] = *(const GAS v2u*)(CV + (size_t)r * CVW + c); gw[q][j] = *(const GAS v2u*)(P + (size_t)r * NWIDE + PC_Z + c); }
#pragma unroll
            for (int j = 0; j < 4; ++j) { const int cl = 256 * (j & 1) + 4 * F.lane; gw[q][4 + j] = *(const GAS v2u*)(P + (size_t)r * NWIDE + (j < 2 ? PC_MO : PC_GR) + cl); }
#pragma unroll
            for (int j = 0; j < 2; ++j) { const int hd_ = (256 * j + 4 * F.lane) >> 7; dn0[q][j] = DEN0[(size_t)r * 4 + hd_]; dn1[q][j] = DEN1[(size_t)r * 4 + hd_]; } }
#pragma unroll
        for (int q = 0; q < 2; ++q) { const int r = rr + q * F.NGW; if (r >= rows) continue;
#pragma unroll
            for (int j = 0; j < 4; ++j) { const int c = 256 * j + 4 * F.lane; const float ds = dsk[c >> 6];
                const v2u a = ya[q][j], b = yb[q][j], x = xw[q][j], z = gw[q][j];
                f32x4 y; y[0] = (bflo(a.x) + bflo(b.x) + ds * bflo(x.x)) * silu_f(bflo(z.x)); y[1] = (bfhi(a.x) + bfhi(b.x) + ds * bfhi(x.x)) * silu_f(bfhi(z.x));
                y[2] = (bflo(a.y) + bflo(b.y) + ds * bflo(x.y)) * silu_f(bflo(z.y)); y[3] = (bfhi(a.y) + bfhi(b.y) + ds * bfhi(x.y)) * silu_f(bfhi(z.y));
                const float ssq = wave_sum((y[0] * y[0] + y[1] * y[1]) + (y[2] * y[2] + y[3] * y[3])); const float rs = 1.f / sqrtf(ssq * (1.f / 256.f) + EPS);
                const f32x4 w = *(const GAS f32x4*)(snw + c); v2u o; o.x = pk2(y[0] * rs * w[0], y[1] * rs * w[1]); o.y = pk2(y[2] * rs * w[2], y[3] * rs * w[3]);
                *(GAS v2u*)(ABR + (size_t)r * D + c) = o; }
#pragma unroll
            for (int j = 0; j < 4; ++j) { const int cl = 256 * (j & 1) + 4 * F.lane, c = (j < 2 ? 1024 : 1536) + cl;
                const v2u a = ya[q][4 + j], b = yb[q][4 + j], g = gw[q][4 + j];
                f32x4 va = {bflo(a.x), bfhi(a.x), bflo(a.y), bfhi(a.y)}, vb = {bflo(b.x), bfhi(b.x), bflo(b.y), bfhi(b.y)};
                f32x4 y = va + vb;
                if (j < 2) { const float d0 = fmaxf(fabsf(dn0[q][j]), 1.0f), d1 = fmaxf(fabsf(dn1[q][j]), 1.0f); y = va / d0 + vb / d1;
                    y[0] *= sigm_f(bflo(g.x)); y[1] *= sigm_f(bfhi(g.x)); y[2] *= sigm_f(bflo(g.y)); y[3] *= sigm_f(bfhi(g.y)); }
                const float mean = half_sum((y[0] + y[1]) + (y[2] + y[3])) * (1.f / 128.f); y = y - mean;
                const float var = half_sum((y[0] * y[0] + y[1] * y[1]) + (y[2] * y[2] + y[3] * y[3])) * (1.f / 128.f); const float rs = 1.f / sqrtf(var + EPS);
                const f32x4 w = *(const GAS f32x4*)((j < 2 ? mnw : gnw) + cl); y = y * rs * w;
                if (j >= 2) { y[0] *= silu_f(bflo(g.x)); y[1] *= silu_f(bfhi(g.x)); y[2] *= silu_f(bflo(g.y)); y[3] *= silu_f(bfhi(g.y)); }
                v2u o; o.x = pk2(y[0], y[1]); o.y = pk2(y[2], y[3]); *(GAS v2u*)(ABR + (size_t)r * D + c) = o; } }
    }
}

constexpr int PH_PER_LAYER = 13, N_PHASES = 2 + PH_PER_LAYER * DEPTH;
__global__ void __launch_bounds__(NWAVES * 64, 2) mk_fwd(Args args) {
    extern __shared__ __attribute__((aligned(16))) unsigned char lds_[];
    LAS unsigned char* lds = (LAS unsigned char*)lds_;
    volatile LAS unsigned* MISC = (volatile LAS unsigned*)(lds + MISC_OFF);
    for (int u = threadIdx.x; u < (LDS_BYTES - LDSCTL_OFF) / 4; u += NWAVES * 64) ((LAS unsigned*)(lds + LDSCTL_OFF))[u] = 0u;
    __syncthreads();
    XcdBarrier bar; bar.bar = (unsigned*)(args.ws + WS_CTL) + CW_BAR; bar.x = 0; bar.st = nullptr;
    if (!MK_PER_PHASE) bar = xcd_barrier_post((unsigned*)(args.ws + WS_CTL) + CW_BAR, MISC + 8);
    const int lo = args.ph_lo, hi = args.ph_hi;
#define IN(k) (lo <= (k) && (k) < hi)
#define SEAM(k) do { if (IN(k) && IN((k) + 1)) { unsigned long long sb_ = 0; if (PROBE_T == 12 && (PROBE_TSEL < 0 || PROBE_TSEL == (k)) && blockIdx.x == PROBE_TB && threadIdx.x == 0) sb_ = wall_clock64(); xcd_barrier(bar); if (PROBE_T == 12 && (PROBE_TSEL < 0 || PROBE_TSEL == (k)) && blockIdx.x == PROBE_TB && threadIdx.x == 0) pt_acc += wall_clock64() - sb_; if (PROBE & 131072) xcd_barrier(bar); } } while (0)
    unsigned long long pt_acc = 0, pt_t0 = 0, blk_t0 = 0;
#define PB0(k) do { if (PROBE_BLK == (k) && threadIdx.x == 0) blk_t0 = wall_clock64(); } while (0)
#define PB1(k) do { if (PROBE_BLK == (k) && threadIdx.x == 0) __hip_atomic_store((unsigned*)(args.ws + WS_CTL) + 65536 + blockIdx.x, (unsigned)(wall_clock64() - blk_t0), __ATOMIC_RELAXED, __HIP_MEMORY_SCOPE_AGENT); } while (0)
#define PB2(k) do { if (PROBE_BLK == (k)) { if (blockIdx.x == 0 && threadIdx.x == 0) { unsigned mx = 0, mn = 0xffffffffu; unsigned long long sm = 0; \
        for (int i_ = 0; i_ < (int)gridDim.x; ++i_) { const unsigned v = __hip_atomic_load((unsigned*)(args.ws + WS_CTL) + 65536 + i_, __ATOMIC_RELAXED, __HIP_MEMORY_SCOPE_AGENT); mx = v > mx ? v : mx; mn = v < mn ? v : mn; sm += v; } \
        const unsigned long long wait = PROBE_BSTAT == 1 ? mx : (PROBE_BSTAT == 2 ? mn : sm / gridDim.x); const unsigned long long t0 = wall_clock64(); while (wall_clock64() - t0 < wait) __builtin_amdgcn_s_sleep(8); } __syncthreads(); } } while (0)
#define PT0(ty) do { if (PROBE_T == (ty) && blockIdx.x == 0 && threadIdx.x == 0) pt_t0 = wall_clock64(); } while (0)
#define PT1(ty) do { if (PROBE_T == (ty) && blockIdx.x == 0 && threadIdx.x == 0) pt_acc += wall_clock64() - pt_t0; } while (0)
#define GEMM_CALL(EPI, Aptr, Bptr, Mr, Nn, Kk, LDA, LDB, ...) do { pg8::Gemm g{Aptr, Bptr, Mr, Nn, Kk, LDA, LDB}; pg8::StaticOrder S; S.init(Mr, Nn, F.G, (int)blockIdx.x); EPI E{__VA_ARGS__}; \
        pg8::gemm_phase<EPI, pg8::StaticOrder, PG8_ALIGN, PG8_SP2>(F.lds + RING_OFF, g, S, E); } while (0)
#define PIECE_CALL(Aptr, Bptr, Mr, Nn, Kslice, LDA, LDB, KS, ...) do { pg8::Gemm g{Aptr, Bptr, Mr, Nn, Kslice, LDA, LDB}; pg8::PieceOrder S; S.init(Mr, Nn, KS, (Kslice) * 2, F.G, (int)blockIdx.x); pg8::EpiF32Part E{__VA_ARGS__}; \
        pg8::gemm_phase<pg8::EpiF32Part, pg8::PieceOrder, PG8_ALIGN, PG8_SP2>(F.lds + RING_OFF, g, S, E); } while (0)
#if PROBE & 4194304
#define PROBE_SCHED pg8::HotOrder
#else
#define PROBE_SCHED pg8::StaticOrder
#endif
#define REP(bit) for (int rep_ = 0; rep_ < ((PROBE & (bit)) ? 2 : 1); ++rep_)
#define WSP(T, off) ((T*)(F.ws + (off)))

    PT0(10); if (IN(0)) { REP(128) { Frame F = mkframe(lds); mod_phase(F); } REP(8) { Frame F = mkframe(lds); convert_weights(F, 0); __syncthreads(); } } SEAM(0); PT1(10);
    PT0(11); if (IN(1)) { Frame F = mkframe(lds); modulate_rows(F, 0, 0, M); } SEAM(1); PT1(11);
    for (int l = 0; l < DEPTH; ++l) {
        const int pb = 2 + PH_PER_LAYER * l;
        const bool lastl = (l == DEPTH - 1);
        const int Mtail = lastl ? ML : M;
        unsigned long long pc0_ = 0, pr0_ = 0, pb0_ = 0;
        if ((PROBE & 16777216) && l == ((PROBE & 134217728) ? 1 : 0) && threadIdx.x == 0) pb0_ = wall_clock64();
        if ((PROBE & 1048576) && l == ((PROBE & 134217728) ? 1 : 0) && blockIdx.x == 0 && threadIdx.x == 0) { pc0_ = clock64(); pr0_ = wall_clock64(); }
        PB0(pb + 0);
        PT0(1);
        if (IN(pb + 0)) { if (PROBE & 65536) { Frame F = mkframe(lds); pg8::Gemm g{WSP(bf16, WS_U), WSP(bf16, WS_WB + WB_FIN), M, NFF, D, D, D}; PROBE_SCHED S; S.init(M, NFF, F.G, (int)blockIdx.x); pg8::EpiNull E{0};
            pg8::gemm_phase<pg8::EpiNull, PROBE_SCHED, PG8_ALIGN, PG8_SP2>(F.lds + RING_OFF, g, S, E); } REP(256) { Frame F = mkframe(lds); GEMM_CALL(pg8::EpiSwiGLU, WSP(bf16, WS_U), WSP(bf16, WS_WB + WB_FIN), M, NFF, D, D, D, WSP(bf16, WS_BIG), DFF); } }
        if ((PROBE & 1048576) && l == ((PROBE & 134217728) ? 1 : 0)) {
            if (blockIdx.x == 0 && threadIdx.x == 0) { const unsigned long long c1 = clock64(), r1 = wall_clock64(); const unsigned long long wait = (PROBE & 2097152) ? 100000ull : ((PROBE & 8388608) ? (c1 - pc0_) * 30ull / 384ull : (c1 - pc0_) * 5000ull / (r1 - pr0_)); const unsigned long long t0 = wall_clock64(); while (wall_clock64() - t0 < wait) __builtin_amdgcn_s_sleep(8); }
            __syncthreads(); }
        if ((PROBE & 16777216) && l == ((PROBE & 134217728) ? 1 : 0)) { if (threadIdx.x == 0) __hip_atomic_store((unsigned*)(args.ws + WS_CTL) + 65536 + blockIdx.x, (unsigned)(wall_clock64() - pb0_), __ATOMIC_RELAXED, __HIP_MEMORY_SCOPE_AGENT); }
        PB1(pb + 0); SEAM(pb + 0); PB2(pb + 0); PT1(1);
        if ((PROBE & 16777216) && l == ((PROBE & 134217728) ? 1 : 0)) { if (blockIdx.x == 0 && threadIdx.x == 0) { unsigned mx = 0, mn = 0xffffffffu; unsigned long long sm = 0;
                for (int i = 0; i < (int)gridDim.x; ++i) { const unsigned v = __hip_atomic_load((unsigned*)(args.ws + WS_CTL) + 65536 + i, __ATOMIC_RELAXED, __HIP_MEMORY_SCOPE_AGENT); mx = v > mx ? v : mx; mn = v < mn ? v : mn; sm += v; }
                const unsigned long long wait = (PROBE & 33554432) ? mx : ((PROBE & 67108864) ? mn : sm / gridDim.x); const unsigned long long t0 = wall_clock64(); while (wall_clock64() - t0 < wait) __builtin_amdgcn_s_sleep(8); }
            __syncthreads(); }
        PB0(pb + 1);
        PT0(2);
        if (IN(pb + 1)) REP(512) { { Frame F = mkframe(lds); GEMM_CALL(pg8::EpiBf16, WSP(bf16, WS_BIG), WSP(bf16, WS_WB + WB_FOUT), ML, D, DFF, DFF, DFF, WSP(bf16, WS_Y), D); }
            { Frame F = mkframe(lds); PIECE_CALL(WSP(bf16, WS_BIG) + (size_t)ML * DFF, WSP(bf16, WS_WB + WB_FOUT), MC, D, DFF / 4, DFF, DFF, 4, WSP(float, WS_YP), D, (size_t)MC * D); } } PB1(pb + 1); SEAM(pb + 1); PB2(pb + 1); PT1(2);
        PB0(pb + 2);
        PT0(7);
        if (IN(pb + 2)) { if (PROBE & 16) { Frame F = mkframe(lds); ln_rows(F, l, 0, 0.5f, l == 0, 0, l, 1, true, false, M, true, true); } Frame F = mkframe(lds); ln_rows(F, l, 0, 0.5f, l == 0, 0, l, 1, true, false, M, false, true); } PB1(pb + 2); SEAM(pb + 2); PB2(pb + 2); PT1(7);
        PB0(pb + 3);
        PT0(3);
        if (IN(pb + 3)) REP(1024) { { Frame F = mkframe(lds); pg8::Gemm g{WSP(bf16, WS_U), WSP(bf16, WS_WB + WB_WIN), M, NIN, D, D, D}; pg8::InProjOrder S; S.init2(M, NWIDE, ML, F.G, (int)blockIdx.x); pg8::EpiInProj E{WSP(bf16, WS_BIG), NWIDE, WSP(float, WS_PN), NWIDE / 256};
              pg8::gemm_phase<pg8::EpiInProj, pg8::InProjOrder, PG8_ALIGN, PG8_SP2>(F.lds + RING_OFF, g, S, E); }
            { Frame F = mkframe(lds); PIECE_CALL(WSP(bf16, WS_U) + (size_t)ML * D, WSP(bf16, WS_WB + WB_WIN) + (size_t)NWIDE * D, MC, 256, D / 8, D, D, 8, WSP(float, WS_PNP), 256, (size_t)MC * 256); } } PB1(pb + 3); SEAM(pb + 3); PB2(pb + 3); PT1(3);
        PB0(pb + 4);
        PT0(8);
        if (IN(pb + 4)) { if (PROBE & 4) { Frame F = mkframe(lds); prep_phase(F, l, 1); } if (PROBE & 32) { Frame F = mkframe(lds); prep_phase(F, l, 2); } Frame F = mkframe(lds); prep_phase(F, l); } PB1(pb + 4); SEAM(pb + 4); PB2(pb + 4); PT1(8);
        PB0(pb + 5);
        PT0(6);
        if (IN(pb + 5)) REP(1) { Frame F = mkframe(lds); scan_phase(F, l); } PB1(pb + 5); SEAM(pb + 5); PB2(pb + 5); PT1(6);
        PB0(pb + 6);
        PT0(9);
        if (IN(pb + 6)) REP(64) { Frame F = mkframe(lds); finish_phase(F, l, Mtail); } PB1(pb + 6); SEAM(pb + 6); PB2(pb + 6); PT1(9);
        PB0(pb + 7);
        PT0(4);
        if (IN(pb + 7)) REP(2048) { Frame F = mkframe(lds); const float* mb = F.in[I_MERGEB] + (size_t)l * 3 * D;
            pg8::Gemm g{WSP(bf16, WS_U), WSP(bf16, WS_WB + WB_BRS), Mtail, D, D, D, D}; pg8::SegOrder S; S.init(Mtail, D, F.G, (int)blockIdx.x); pg8::EpiBranchSeg E{WSP(bf16, WS_BIG) + PC_GATE, NWIDE, mb, WSP(bf16, WS_YS), WSP(bf16, WS_CV), D};
            pg8::gemm_phase<pg8::EpiBranchSeg, pg8::SegOrder, PG8_ALIGN, PG8_SP2>(F.lds + RING_OFF, g, S, E); } PB1(pb + 7); SEAM(pb + 7); PB2(pb + 7); PT1(4);
        PB0(pb + 8);
        PT0(5);
        if (IN(pb + 8)) REP(4096) { { Frame F = mkframe(lds); GEMM_CALL(pg8::EpiBf16, WSP(bf16, WS_CV), WSP(bf16, WS_WB + WB_OUT), ML, D, D, D, D, WSP(bf16, WS_Y), D); }
            if (!lastl) { Frame F = mkframe(lds); PIECE_CALL(WSP(bf16, WS_CV) + (size_t)ML * D, WSP(bf16, WS_WB + WB_OUT), MC, D, D / 4, D, D, 4, WSP(float, WS_YP), D, (size_t)MC * D); } } PB1(pb + 8); SEAM(pb + 8); PB2(pb + 8); PT1(5);
        PB0(pb + 9);
        PT0(7);
        if (IN(pb + 9)) { if (PROBE & 16) { Frame F = mkframe(lds); ln_rows(F, l, 1, 1.0f, false, 1, l, 2, true, false, Mtail, true, true); } Frame F = mkframe(lds); ln_rows(F, l, 1, 1.0f, false, 1, l, 2, true, false, Mtail, false, true); } PB1(pb + 9); SEAM(pb + 9); PB2(pb + 9); PT1(7);
        PB0(pb + 10);
        PT0(1);
        if (IN(pb + 10)) REP(256) { Frame F = mkframe(lds); GEMM_CALL(pg8::EpiSwiGLU, WSP(bf16, WS_U), WSP(bf16, WS_WB + WB_FIN) + (size_t)NFF * D, Mtail, NFF, D, D, D, WSP(bf16, WS_BIG), DFF); } PB1(pb + 10); SEAM(pb + 10); PB2(pb + 10); PT1(1);
        PB0(pb + 11);
        PT0(2);
        if (IN(pb + 11)) REP(512) { { Frame F = mkframe(lds); GEMM_CALL(pg8::EpiBf16, WSP(bf16, WS_BIG), WSP(bf16, WS_WB + WB_FOUT) + (size_t)D * DFF, ML, D, DFF, DFF, DFF, WSP(bf16, WS_Y), D); }
            if (!lastl) { Frame F = mkframe(lds); PIECE_CALL(WSP(bf16, WS_BIG) + (size_t)ML * DFF, WSP(bf16, WS_WB + WB_FOUT) + (size_t)D * DFF, MC, D, DFF / 4, DFF, DFF, 4, WSP(float, WS_YP), D, (size_t)MC * D); } } PB1(pb + 11); SEAM(pb + 11); PB2(pb + 11); PT1(2);
        PB0(pb + 12);
        PT0(7);
        if (IN(pb + 12)) { if (PROBE & 16) { Frame F = mkframe(lds); ln_rows(F, l, 2, 0.5f, false, 2, lastl ? l : l + 1, 0, !lastl, lastl, Mtail, true, true); } Frame F = mkframe(lds); ln_rows(F, l, 2, 0.5f, false, 2, lastl ? l : l + 1, 0, !lastl, lastl, Mtail, false, true);
            if (!lastl) REP(8) { convert_weights(F, l + 1); __syncthreads(); } } PB1(pb + 12); SEAM(pb + 12); PB2(pb + 12); PT1(7);
    }
    if (PROBE_T != 0) { if (blockIdx.x == (PROBE_T == 12 ? PROBE_TB : 0) && threadIdx.x == 0) { const unsigned long long t0 = wall_clock64(); while (wall_clock64() - t0 < pt_acc) __builtin_amdgcn_s_sleep(8); } __syncthreads(); }
#undef IN
#undef SEAM
}

extern "C" void kernel_launch(void* const* d_in, const int* in_sizes, int n_in, void* d_out, int out_size, void* d_ws, size_t ws_size, hipStream_t stream) {
    static int grid = 0;
    if (grid == 0) {
        if (n_in != 29 || in_sizes[0] != ML * D || out_size != ML * D || ws_size < WS_END) { fprintf(stderr, "kernel_launch: unexpected shapes (n_in %d, out %d, ws %zu, need %zu); nothing launched\n", n_in, out_size, ws_size, (size_t)WS_END); grid = -1; return; }
        int dev = 0, cus = 0, per_cu = 0;
        if (hipGetDevice(&dev) != hipSuccess || hipDeviceGetAttribute(&cus, hipDeviceAttributeMultiprocessorCount, dev) != hipSuccess) { fprintf(stderr, "kernel_launch: device query failed\n"); grid = -1; return; }
        if (hipFuncSetAttribute((const void*)mk_fwd, hipFuncAttributeMaxDynamicSharedMemorySize, LDS_BYTES) != hipSuccess) { fprintf(stderr, "kernel_launch: hipFuncSetAttribute failed\n"); grid = -1; return; }
        if (hipOccupancyMaxActiveBlocksPerMultiprocessor(&per_cu, (const void*)mk_fwd, NWAVES * 64, LDS_BYTES) != hipSuccess || per_cu < 1)
            fprintf(stderr, "kernel_launch: note: occupancy query reports %d workgroups per CU\n", per_cu);
        (void)hipGetLastError();
        grid = cus;
    }
    if (grid < 0) return;
    if (hipMemsetAsync((char*)d_ws + WS_CTL, 0, CTL_ZERO_BYTES, stream) != hipSuccess) { fprintf(stderr, "kernel_launch: memset failed\n"); return; }
    Args a{};
    for (int i = 0; i < 29; ++i) a.in[i] = (const float*)d_in[i];
    a.out = (float*)d_out; a.ws = (unsigned char*)d_ws;
#if MK_PER_PHASE
    for (int ph = 0; ph < N_PHASES; ++ph) { a.ph_lo = ph; a.ph_hi = ph + 1; hipLaunchKernelGGL(mk_fwd, dim3(grid), dim3(NWAVES * 64), LDS_BYTES, stream, a); }
#else
    a.ph_lo = 0; a.ph_hi = N_PHASES;
    hipLaunchKernelGGL(mk_fwd, dim3(grid), dim3(NWAVES * 64), LDS_BYTES, stream, a);
#endif
    const hipError_t le = hipPeekAtLastError();
    if (le != hipSuccess) fprintf(stderr, "kernel_launch: launch failed: %s\n", hipGetErrorName(le));
}
```

```cpp
#include <hip/hip_runtime.h>
#include <cstdio>
#include <cstdint>

#ifndef MK_PER_PHASE
#define MK_PER_PHASE 0
#endif
#ifndef PROBE_T
#define PROBE_T 0
#endif
#ifndef PROBE_BLK
#define PROBE_BLK -1
#endif
#ifndef PROBE_BSTAT
#define PROBE_BSTAT 1
#endif
#ifndef PROBE
#define PROBE 0
#endif

namespace pg8 {
#define PG8_LAS __attribute__((address_space(3)))
typedef unsigned short bf16_t;
typedef short bf16x8 __attribute__((ext_vector_type(8)));
typedef float f32x4 __attribute__((ext_vector_type(4)));
typedef unsigned u32x4 __attribute__((ext_vector_type(4)));
constexpr int BM = 256, BK = 64, HALF = 128, HTB = HALF * BK * 2, STAGE_BYTES = 8 * HTB, NXCD = 8, WGM = 8;

__host__ __device__ __forceinline__ int lds_byte(int r, int c) { const int st = (r >> 4) * 2 + (c >> 5), rr = r & 15, cc = c & 31, ob = rr * 64 + cc * 2; return st * 1024 + (ob ^ (((ob >> 9) & 1) << 5)); }
__host__ __device__ __forceinline__ void stage_rc(int b, int& R, int& C) { const int st = b / 1024, sb = b % 1024, swz = sb ^ (((sb >> 9) & 1) << 5); R = (st >> 1) * 16 + swz / 64; C = (st & 1) * 32 + (swz % 64) / 2; }
__host__ __device__ __forceinline__ int perm32(int rho) { const int n = rho >> 4, i = rho & 15; return 8 * (i >> 2) + 4 * n + (i & 3); }

struct Unit { int pm, pn, koff, part, nt; };
struct Gemm { const bf16_t* A; const bf16_t* Bt; int M, N, K, lda, ldb; };

struct StaticOrder {
    int nM, nN, nwg, G, c;
    __host__ __device__ void init(int M, int N, int G_, int c_) { nM = M / BM; nN = N / BM; nwg = nM * nN; G = G_; c = c_; }
    __host__ __device__ bool next(int i, Unit& u) const { return at((long)i * G + c, u); }
    __host__ __device__ bool at(long L, Unit& u) const {
        if (L >= nwg) return false;
        int wgid = (int)L; { const int q = nwg / NXCD, r = nwg % NXCD, xcd = wgid % NXCD, off = wgid / NXCD; wgid = (xcd < r ? xcd * (q + 1) : r * (q + 1) + (xcd - r) * q) + off; }
        const int nig = WGM * nN, gid = wgid / nig, fm = gid * WGM, gsz = (nM - fm) < WGM ? (nM - fm) : WGM;
        u.pm = fm + ((wgid % nig) % gsz); u.pn = (wgid % nig) / gsz; u.koff = 0; u.part = 0; u.nt = 0; return true;
    }
    __device__ __forceinline__ void a_ready(const Unit&) const {}
    __device__ __forceinline__ void done(const Unit&) const {}
};
__host__ __device__ __forceinline__ int partA_tile(int a) { return a < 12 ? 4 + a : (a < 16 ? 18 + (a - 12) : 48); }
__host__ __device__ __forceinline__ int partB_tile(int q) { return q < 4 ? q : (q < 6 ? 16 + (q - 4) : 22 + (q - 6)); }
struct InProjAOrder {
    StaticOrder A, B; int nbx, G, c;
    __host__ __device__ void init(int M, int MB, int nbx_, int G_, int c_) { A.init(M, 17 * BM, G_, c_); B.init(MB, 32 * BM, G_, c_); nbx = nbx_; G = G_; c = c_; }
    __host__ __device__ bool next(int i, Unit& u) const { const long L = (long)i * G + c;
        if (L < A.nwg) { A.at(L, u); u.pn = partA_tile(u.pn); return true; }
        const long Lb = L - A.nwg; if (Lb >= nbx) return false; if (!B.at(Lb + 4, u)) return false; u.pn = partB_tile(u.pn); return true; }
    __device__ __forceinline__ void a_ready(const Unit&) const {}
    __device__ __forceinline__ void done(const Unit&) const {}
};
struct InProjBOrder {
    StaticOrder B; int nbx, G, c, qS, qM, qG;
    __host__ __device__ void init(int MB, int nbx_, int qS_, int qM_, int qG_, int G_, int c_) { B.init(MB, 32 * BM, G_, c_); nbx = nbx_; G = G_; c = c_; qS = qS_; qM = qM_; qG = qG_; }
    __host__ __device__ bool next(int i, Unit& u) const { long pos;
        if (G != 256) pos = (long)i * G + c;
        else if (c < 128) { if (i >= qS) return false; pos = (long)i * 128 + c; }
        else if (c < 192) { if (i >= qM) return false; pos = 128L * qS + (long)i * 64 + (c - 128); }
        else { if (i >= qG) return false; pos = 128L * qS + 64L * qM + (long)i * 64 + (c - 192); }
        long idx = 4 + nbx + pos; if (idx >= B.nwg) { idx -= B.nwg; if (idx >= 4) return false; }
        if (!B.at(idx, u)) return false; u.pn = partB_tile(u.pn); return true; }
    __device__ __forceinline__ void a_ready(const Unit&) const {}
    __device__ __forceinline__ void done(const Unit&) const {}
};
struct HotOrder : StaticOrder {
    __host__ __device__ bool next(int i, Unit& u) const { if (!StaticOrder::next(i, u)) return false; u.pm = c & 3; u.pn = (c >> 2) & 3; return true; }
};
struct SegOrder : StaticOrder {
    __host__ __device__ bool next(int i, Unit& u) const { const int seg = i % 3; if (!StaticOrder::next(i / 3, u)) return false; u.part = seg; u.koff = seg == 0 ? 0 : (seg == 1 ? 2048 : 3072); u.nt = seg == 0 ? 16 : 8; return true; }
};
struct PieceOrder {
    int nN, np, KS, kslice_bytes, G, c;
    __host__ __device__ void init(int M, int N, int KS_, int kslice_bytes_, int G_, int c_) { nN = N / BM; np = (M / BM) * nN * KS_; KS = KS_; kslice_bytes = kslice_bytes_; G = G_; c = c_; }
    __host__ __device__ bool next(int i, Unit& u) const { const long L = (long)i * G + c; if (L >= np) return false; const int p = (int)L, t = p / KS, ks = p % KS; u.pm = t / nN; u.pn = t % nN; u.koff = ks * kslice_bytes; u.part = ks; u.nt = 0; return true; }
    __device__ __forceinline__ void a_ready(const Unit&) const {}
    __device__ __forceinline__ void done(const Unit&) const {}
};

__device__ __forceinline__ unsigned cvt_pk_bf16(float lo, float hi) { unsigned r; asm volatile("v_cvt_pk_bf16_f32 %0, %1, %2" : "=v"(r) : "v"(lo), "v"(hi)); return r; }
__device__ __forceinline__ float bf_lo(unsigned w) { return __uint_as_float(w << 16); }
__device__ __forceinline__ float bf_hi(unsigned w) { return __uint_as_float(w & 0xffff0000u); }
__device__ __forceinline__ float fsigmoid(float x) { return __builtin_amdgcn_rcpf(1.0f + __expf(-x)); }

struct EpiBf16 {
    static constexpr bool PERM = true, AFTER_DRAIN = false;
    bf16_t* O; int ldc;
    __device__ __forceinline__ void operator()(const f32x4 (&acc)[2][2][4][2], const Unit& u, int wr, int wc, int fr, int fq) const {
        const int row0 = u.pm * BM + wr * 64 + fr, col0 = u.pn * BM + wc * 32 + 8 * fq;
#pragma unroll
        for (int ai = 0; ai < 2; ++ai)
#pragma unroll
            for (int m = 0; m < 4; ++m) { bf16_t* rowp = O + (size_t)(row0 + ai * HALF + m * 16) * ldc + col0;
#pragma unroll
                for (int bj = 0; bj < 2; ++bj) { const f32x4 v0 = acc[ai][bj][m][0], v1 = acc[ai][bj][m][1];
                    u32x4 w; w.x = cvt_pk_bf16(v0[0], v0[1]); w.y = cvt_pk_bf16(v0[2], v0[3]); w.z = cvt_pk_bf16(v1[0], v1[1]); w.w = cvt_pk_bf16(v1[2], v1[3]);
                    *(u32x4*)(rowp + bj * HALF) = w; } }
    }
};
struct EpiSwiGLU {
    static constexpr bool PERM = true, AFTER_DRAIN = false;
    bf16_t* O; int ldc;
    __device__ __forceinline__ void operator()(const f32x4 (&acc)[2][2][4][2], const Unit& u, int wr, int wc, int fr, int fq) const {
        const int row0 = u.pm * BM + wr * 64 + fr, col0 = u.pn * HALF + wc * 32 + 8 * fq;
#pragma unroll
        for (int ai = 0; ai < 2; ++ai)
#pragma unroll
            for (int m = 0; m < 4; ++m) { bf16_t* rowp = O + (size_t)(row0 + ai * HALF + m * 16) * ldc + col0;
                float o[8];
#pragma unroll
                for (int n = 0; n < 2; ++n)
#pragma unroll
                    for (int j = 0; j < 4; ++j) { const float a = acc[ai][0][m][n][j], g = acc[ai][1][m][n][j]; o[n * 4 + j] = a * g * fsigmoid(g); }
                u32x4 w; w.x = cvt_pk_bf16(o[0], o[1]); w.y = cvt_pk_bf16(o[2], o[3]); w.z = cvt_pk_bf16(o[4], o[5]); w.w = cvt_pk_bf16(o[6], o[7]);
                *(u32x4*)rowp = w; }
    }
};
struct EpiF32Part {
    static constexpr bool PERM = true, AFTER_DRAIN = false;
    float* C; int ldc; size_t part_stride;
    __device__ __forceinline__ void operator()(const f32x4 (&acc)[2][2][4][2], const Unit& u, int wr, int wc, int fr, int fq) const {
        const int row0 = u.pm * BM + wr * 64 + fr, col0 = u.pn * BM + wc * 32 + 8 * fq; float* base = C + (size_t)u.part * part_stride;
#pragma unroll
        for (int ai = 0; ai < 2; ++ai)
#pragma unroll
            for (int m = 0; m < 4; ++m) { float* rowp = base + (size_t)(row0 + ai * HALF + m * 16) * ldc + col0;
#pragma unroll
                for (int bj = 0; bj < 2; ++bj) { *(f32x4*)(rowp + bj * HALF) = acc[ai][bj][m][0]; *(f32x4*)(rowp + bj * HALF + 4) = acc[ai][bj][m][1]; } }
    }
};
struct EpiNull {
    static constexpr bool PERM = true, AFTER_DRAIN = false;
    int dummy;
    __device__ __forceinline__ void operator()(const f32x4 (&acc)[2][2][4][2], const Unit&, int, int, int, int) const {
#pragma unroll
        for (int ai = 0; ai < 2; ++ai)
#pragma unroll
            for (int m = 0; m < 4; ++m)
#pragma unroll
                for (int bj = 0; bj < 2; ++bj) { asm volatile("" :: "v"(acc[ai][bj][m][0]), "v"(acc[ai][bj][m][1])); }
    }
};
struct EpiInProj {
    static constexpr bool PERM = true, AFTER_DRAIN = false;
    bf16_t* P; int ldp; float* PN; int nwide_tiles;
    __device__ __forceinline__ void operator()(const f32x4 (&acc)[2][2][4][2], const Unit& u, int wr, int wc, int fr, int fq) const {
        const int row0 = u.pm * BM + wr * 64 + fr;
        if (u.pn < nwide_tiles) {
            const int col0 = u.pn * BM + wc * 32 + 8 * fq;
#pragma unroll
            for (int ai = 0; ai < 2; ++ai)
#pragma unroll
                for (int m = 0; m < 4; ++m) { bf16_t* rowp = P + (size_t)(row0 + ai * HALF + m * 16) * ldp + col0;
#pragma unroll
                    for (int bj = 0; bj < 2; ++bj) { const f32x4 v0 = acc[ai][bj][m][0], v1 = acc[ai][bj][m][1];
                        u32x4 w; w.x = cvt_pk_bf16(v0[0], v0[1]); w.y = cvt_pk_bf16(v0[2], v0[3]); w.z = cvt_pk_bf16(v1[0], v1[1]); w.w = cvt_pk_bf16(v1[2], v1[3]);
                        *(u32x4*)(rowp + bj * HALF) = w; } }
        } else {
            const int col0 = wc * 32 + 8 * fq;
#pragma unroll
            for (int ai = 0; ai < 2; ++ai)
#pragma unroll
                for (int m = 0; m < 4; ++m) { float* rowp = PN + (size_t)(row0 + ai * HALF + m * 16) * 256 + col0;
#pragma unroll
                    for (int bj = 0; bj < 2; ++bj) { *(f32x4*)(rowp + bj * HALF) = acc[ai][bj][m][0]; *(f32x4*)(rowp + bj * HALF + 4) = acc[ai][bj][m][1]; } }
        }
    }
};
template <int STAGE> struct EpiBranch {
    static constexpr bool PERM = true, AFTER_DRAIN = false;
    const bf16_t* G; int ldg; const float* mb; bf16_t* MACC; bf16_t* MRG; int ldc;
    __device__ __forceinline__ void operator()(const f32x4 (&acc)[2][2][4][2], const Unit& u, int wr, int wc, int fr, int fq) const {
        const int row0 = u.pm * BM + wr * 64 + fr, col0 = u.pn * BM + wc * 32 + 8 * fq;
#pragma unroll
        for (int ai = 0; ai < 2; ++ai)
#pragma unroll
            for (int m = 0; m < 4; ++m) { const size_t row = (size_t)(row0 + ai * HALF + m * 16);
#pragma unroll
                for (int bj = 0; bj < 2; ++bj) { const int col = col0 + bj * HALF;
                    const u32x4 gw = *(const u32x4*)(G + row * ldg + col); const f32x4 b0 = *(const f32x4*)(mb + col), b1 = *(const f32x4*)(mb + col + 4);
                    f32x4 g0, g1;
                    g0[0] = fsigmoid(bf_lo(gw.x) + b0[0]); g0[1] = fsigmoid(bf_hi(gw.x) + b0[1]); g0[2] = fsigmoid(bf_lo(gw.y) + b0[2]); g0[3] = fsigmoid(bf_hi(gw.y) + b0[3]);
                    g1[0] = fsigmoid(bf_lo(gw.z) + b1[0]); g1[1] = fsigmoid(bf_hi(gw.z) + b1[1]); g1[2] = fsigmoid(bf_lo(gw.w) + b1[2]); g1[3] = fsigmoid(bf_hi(gw.w) + b1[3]);
                    f32x4 v0 = g0 * acc[ai][bj][m][0], v1 = g1 * acc[ai][bj][m][1];
                    bf16_t* mp = (STAGE <= 1 ? MACC : MRG) + row * ldc + col;
                    if (STAGE >= 1) { const u32x4 pw = *(const u32x4*)(MACC + row * ldc + col);
                        v0[0] += bf_lo(pw.x); v0[1] += bf_hi(pw.x); v0[2] += bf_lo(pw.y); v0[3] += bf_hi(pw.y); v1[0] += bf_lo(pw.z); v1[1] += bf_hi(pw.z); v1[2] += bf_lo(pw.w); v1[3] += bf_hi(pw.w); }
                    u32x4 w; w.x = cvt_pk_bf16(v0[0], v0[1]); w.y = cvt_pk_bf16(v0[2], v0[3]); w.z = cvt_pk_bf16(v1[0], v1[1]); w.w = cvt_pk_bf16(v1[2], v1[3]);
                    *(u32x4*)mp = w; } }
    }
};

struct EpiBranchSeg {
    static constexpr bool PERM = true, AFTER_DRAIN = false;
    const bf16_t* G; int ldg; const float* mb; bf16_t* MACC; bf16_t* MRG; int ldc;
    __device__ __forceinline__ void operator()(const f32x4 (&acc)[2][2][4][2], const Unit& u, int wr, int wc, int fr, int fq) const {
        const int row0 = u.pm * BM + wr * 64 + fr, col0 = u.pn * BM + wc * 32 + 8 * fq; const int part = u.part;
        const bf16_t* Gp = G + part * ldc; const float* mbp = mb + part * ldc; bf16_t* outp = part == 2 ? MRG : MACC;
#pragma unroll
        for (int ai = 0; ai < 2; ++ai)
#pragma unroll
            for (int m = 0; m < 4; ++m) { const size_t row = (size_t)(row0 + ai * HALF + m * 16);
#pragma unroll
                for (int bj = 0; bj < 2; ++bj) { const int col = col0 + bj * HALF;
                    const u32x4 gw = *(const u32x4*)(Gp + row * ldg + col); const f32x4 b0 = *(const f32x4*)(mbp + col), b1 = *(const f32x4*)(mbp + col + 4);
                    f32x4 g0, g1;
                    g0[0] = fsigmoid(bf_lo(gw.x) + b0[0]); g0[1] = fsigmoid(bf_hi(gw.x) + b0[1]); g0[2] = fsigmoid(bf_lo(gw.y) + b0[2]); g0[3] = fsigmoid(bf_hi(gw.y) + b0[3]);
                    g1[0] = fsigmoid(bf_lo(gw.z) + b1[0]); g1[1] = fsigmoid(bf_hi(gw.z) + b1[1]); g1[2] = fsigmoid(bf_lo(gw.w) + b1[2]); g1[3] = fsigmoid(bf_hi(gw.w) + b1[3]);
                    f32x4 v0 = g0 * acc[ai][bj][m][0], v1 = g1 * acc[ai][bj][m][1];
                    if (part >= 1) { const u32x4 pw = *(const u32x4*)(MACC + row * ldc + col);
                        v0[0] += bf_lo(pw.x); v0[1] += bf_hi(pw.x); v0[2] += bf_lo(pw.y); v0[3] += bf_hi(pw.y); v1[0] += bf_lo(pw.z); v1[1] += bf_hi(pw.z); v1[2] += bf_lo(pw.w); v1[3] += bf_hi(pw.w); }
                    u32x4 w; w.x = cvt_pk_bf16(v0[0], v0[1]); w.y = cvt_pk_bf16(v0[2], v0[3]); w.z = cvt_pk_bf16(v1[0], v1[1]); w.w = cvt_pk_bf16(v1[2], v1[3]);
                    *(u32x4*)(outp + row * ldc + col) = w; } }
    }
};

template <class Epi, class Sched, bool ALIGN_EPI = false, bool SP2 = false>
__device__ __forceinline__ void gemm_phase(PG8_LAS unsigned char* lds, const Gemm g, const Sched& S, const Epi& E) {
    int tid_ = threadIdx.x; asm volatile("" : "+v"(tid_));
    const int tid = tid_, wid = __builtin_amdgcn_readfirstlane(tid >> 6), lane = tid & 63, wr = wid >> 2, wc = wid & 3, fr = lane & 15, fq = lane >> 4;
    const int K = g.K, nt_def = K / BK;
    unsigned voffA[2], voffB[2];
#pragma unroll
    for (int i = 0; i < 2; ++i) { int R, C; stage_rc(tid * 16 + i * 8192, R, C); const int Rb = Epi::PERM ? ((R & ~31) + perm32(R & 31)) : R;
        voffA[i] = (unsigned)(R * g.lda + C) * 2u; voffB[i] = (unsigned)(Rb * g.ldb + C) * 2u; }
    const size_t kstep = (size_t)(BK * 2);
    const size_t hstepA = (size_t)HALF * g.lda * 2, hstepB = (size_t)HALF * g.ldb * 2;
    const size_t tstepA = 2 * hstepA, tstepB = 2 * hstepB;
    const unsigned ldsw = (unsigned)wid * 1024u;
    const int aoff = lds_byte(wr * 64 + fr, fq * 8), boff = lds_byte(wc * 32 + fr, fq * 8);
#define PG8_SA(b, h) (((b) * 2 + (h)) * HTB)
#define PG8_SB(b, h) ((4 + (b) * 2 + (h)) * HTB)
#define PG8_STAGE(bufoff, gbase, voff) do { _Pragma("unroll") for (int _i = 0; _i < 2; ++_i) \
        __builtin_amdgcn_global_load_lds((const unsigned*)((const char*)(gbase) + (voff)[_i]), (PG8_LAS unsigned*)(lds + (bufoff) + ldsw + _i * 8192), 16, 0, 0); } while (0)
#define PG8_LDA(dst, b, h) do { _Pragma("unroll") for (int m = 0; m < 4; ++m) _Pragma("unroll") for (int k = 0; k < 2; ++k) dst[m][k] = *(const PG8_LAS bf16x8*)(lds + PG8_SA(b, h) + aoff + m * 2048 + k * 1024); } while (0)
#define PG8_LDB(dst, b, h) do { _Pragma("unroll") for (int n = 0; n < 2; ++n) _Pragma("unroll") for (int k = 0; k < 2; ++k) dst[n][k] = *(const PG8_LAS bf16x8*)(lds + PG8_SB(b, h) + boff + n * 2048 + k * 1024); } while (0)
#define PG8_MMA(ai, bj, At, Bt) do { __builtin_amdgcn_s_setprio(1); _Pragma("unroll") for (int m = 0; m < 4; ++m) _Pragma("unroll") for (int n = 0; n < 2; ++n) _Pragma("unroll") for (int k = 0; k < 2; ++k) \
        acc[ai][bj][m][n] = __builtin_amdgcn_mfma_f32_16x16x32_bf16(Bt[n][k], At[m][k], acc[ai][bj][m][n], 0, 0, 0); __builtin_amdgcn_s_setprio(0); } while (0)
#define PG8_WAIT_V(n) asm volatile("s_waitcnt vmcnt(" #n ")" ::: "memory")
#define PG8_WAIT_L(n) asm volatile("s_waitcnt lgkmcnt(" #n ")" ::: "memory")
#define PG8_BAR __builtin_amdgcn_s_barrier()
#define PG8_SCHED __builtin_amdgcn_sched_barrier(0)
    Unit cur, nxt; int ui = 0;
    if (!S.next(0, cur)) return;
    f32x4 acc[2][2][4][2];
#pragma unroll
    for (int a = 0; a < 2; ++a)
#pragma unroll
        for (int b = 0; b < 2; ++b)
#pragma unroll
            for (int m = 0; m < 4; ++m)
#pragma unroll
                for (int n = 0; n < 2; ++n) acc[a][b][m][n] = (f32x4){0.f, 0.f, 0.f, 0.f};
    bf16x8 At[4][2], B0[2][2], B1[2][2];
    const char* cA = (const char*)g.A + (size_t)cur.pm * tstepA + cur.koff; const char* cB = (const char*)g.Bt + (size_t)cur.pn * tstepB + cur.koff;
    S.a_ready(cur);
    if constexpr (SP2) {
        PG8_STAGE(PG8_SB(0, 0), cB, voffB); PG8_STAGE(PG8_SB(0, 1), cB + hstepB, voffB); PG8_STAGE(PG8_SA(0, 0), cA, voffA); PG8_STAGE(PG8_SA(0, 1), cA + hstepA, voffA);
        if (wr == 1) PG8_BAR;
        PG8_WAIT_V(2); PG8_BAR;
        PG8_STAGE(PG8_SB(1, 0), cB + kstep, voffB); PG8_STAGE(PG8_SA(1, 0), cA + kstep, voffA); PG8_STAGE(PG8_SB(1, 1), cB + hstepB + kstep, voffB);
        PG8_WAIT_V(6); PG8_BAR;
    } else {
        PG8_STAGE(PG8_SB(0, 0), cB, voffB); PG8_STAGE(PG8_SA(0, 0), cA, voffA); PG8_STAGE(PG8_SB(0, 1), cB + hstepB, voffB); PG8_STAGE(PG8_SA(0, 1), cA + hstepA, voffA);
        if (wr == 1) PG8_BAR;
        PG8_WAIT_V(4); PG8_BAR;
        PG8_STAGE(PG8_SB(1, 0), cB + kstep, voffB); PG8_STAGE(PG8_SA(1, 0), cA + kstep, voffA); PG8_STAGE(PG8_SB(1, 1), cB + hstepB + kstep, voffB);
        PG8_WAIT_V(6); PG8_BAR;
    }
    for (;;) {
        const bool has_next = S.next(ui + 1, nxt);
        const char* nA = has_next ? (const char*)g.A + (size_t)nxt.pm * tstepA + nxt.koff : cA; const char* nB = has_next ? (const char*)g.Bt + (size_t)nxt.pn * tstepB + nxt.koff : cB;
        const int nt = cur.nt ? cur.nt : nt_def;
        asm volatile(".p2align 8" ::: "memory");
        for (int t = 0; t < nt; t += 2) {
            const bool last = (t == nt - 2);
            const char* a1 = cA + (size_t)(t + 1) * kstep;
            const char* a2 = last ? nA : cA + (size_t)(t + 2) * kstep; const char* b2 = last ? nB : cB + (size_t)(t + 2) * kstep;
            const char* a3 = a2 + kstep; const char* b3 = b2 + kstep;
            if (last && has_next) S.a_ready(nxt);
            if constexpr (SP2) {
            PG8_LDB(B0, 0, 0); PG8_LDB(B1, 0, 1); PG8_SCHED; PG8_LDA(At, 0, 0); PG8_STAGE(PG8_SA(1, 1), a1 + hstepA, voffA);
            PG8_WAIT_V(8); PG8_WAIT_L(0); PG8_BAR; PG8_MMA(0, 0, At, B0); PG8_MMA(0, 1, At, B1); PG8_BAR; PG8_SCHED;
            PG8_LDA(At, 0, 1); PG8_STAGE(PG8_SB(0, 0), b2, voffB); PG8_STAGE(PG8_SB(0, 1), b2 + hstepB, voffB); PG8_STAGE(PG8_SA(0, 0), a2, voffA);
            PG8_WAIT_V(8); PG8_WAIT_L(0); PG8_BAR; PG8_MMA(1, 0, At, B0); PG8_MMA(1, 1, At, B1); PG8_BAR; PG8_SCHED;
            PG8_LDB(B0, 1, 0); PG8_LDB(B1, 1, 1); PG8_SCHED; PG8_LDA(At, 1, 0); PG8_STAGE(PG8_SA(0, 1), a2 + hstepA, voffA);
            PG8_WAIT_V(8); PG8_WAIT_L(0); PG8_BAR; PG8_MMA(0, 0, At, B0); PG8_MMA(0, 1, At, B1); PG8_BAR; PG8_SCHED;
            PG8_LDA(At, 1, 1); PG8_STAGE(PG8_SB(1, 0), b3, voffB); PG8_STAGE(PG8_SB(1, 1), b3 + hstepB, voffB); PG8_STAGE(PG8_SA(1, 0), a3, voffA);
            PG8_WAIT_V(8); PG8_WAIT_L(0); PG8_BAR; PG8_MMA(1, 0, At, B0); PG8_MMA(1, 1, At, B1); PG8_BAR; PG8_SCHED;
            } else {
            PG8_LDB(B0, 0, 0); PG8_SCHED; PG8_LDA(At, 0, 0); PG8_STAGE(PG8_SA(1, 1), a1 + hstepA, voffA);
            PG8_WAIT_L(8); PG8_BAR; PG8_WAIT_L(0); PG8_MMA(0, 0, At, B0); PG8_BAR; PG8_SCHED;
            PG8_LDB(B1, 0, 1); PG8_STAGE(PG8_SB(0, 0), b2, voffB);
            PG8_BAR; PG8_WAIT_L(0); PG8_MMA(0, 1, At, B1); PG8_BAR;
            PG8_LDA(At, 0, 1); PG8_STAGE(PG8_SA(0, 0), a2, voffA);
            PG8_BAR; PG8_WAIT_L(0); PG8_MMA(1, 0, At, B0); PG8_BAR; PG8_SCHED;
            PG8_STAGE(PG8_SB(0, 1), b2 + hstepB, voffB);
            PG8_WAIT_V(6); PG8_BAR; PG8_MMA(1, 1, At, B1); PG8_BAR;
            PG8_LDB(B0, 1, 0); PG8_SCHED; PG8_LDA(At, 1, 0); PG8_STAGE(PG8_SA(0, 1), a2 + hstepA, voffA);
            PG8_WAIT_L(8); PG8_BAR; PG8_WAIT_L(0); PG8_MMA(0, 0, At, B0); PG8_BAR; PG8_SCHED;
            PG8_LDB(B1, 1, 1); PG8_STAGE(PG8_SB(1, 0), b3, voffB);
            PG8_BAR; PG8_WAIT_L(0); PG8_MMA(0, 1, At, B1); PG8_BAR;
            PG8_LDA(At, 1, 1); PG8_STAGE(PG8_SA(1, 0), a3, voffA);
            PG8_BAR; PG8_WAIT_L(0); PG8_MMA(1, 0, At, B0); PG8_BAR; PG8_SCHED;
            PG8_STAGE(PG8_SB(1, 1), b3 + hstepB, voffB);
            PG8_WAIT_V(6); PG8_BAR; PG8_MMA(1, 1, At, B1); PG8_BAR;
            }
        }
        if constexpr (ALIGN_EPI) { if (wr == 0) PG8_BAR; }
        if constexpr (!Epi::AFTER_DRAIN) { E(acc, cur, wr, wc, fr, fq); S.done(cur); }
        if (!has_next) break;
#pragma unroll
        for (int a = 0; a < 2; ++a)
#pragma unroll
            for (int b = 0; b < 2; ++b)
#pragma unroll
                for (int m = 0; m < 4; ++m)
#pragma unroll
                    for (int n = 0; n < 2; ++n) acc[a][b][m][n] = (f32x4){0.f, 0.f, 0.f, 0.f};
        cur = nxt; cA = nA; cB = nB; ++ui;
        if constexpr (ALIGN_EPI) { if (wr == 1) PG8_BAR; }
    }
    PG8_WAIT_V(0);
    if constexpr (!ALIGN_EPI) { if (wr == 0) PG8_BAR; }
    PG8_BAR;
#undef PG8_SA
#undef PG8_SB
#undef PG8_STAGE
#undef PG8_LDA
#undef PG8_LDB
#undef PG8_MMA
#undef PG8_WAIT_V
#undef PG8_WAIT_L
#undef PG8_BAR
#undef PG8_SCHED
}
}

#define PG8_SP2 true
#define PG8_ALIGN true

constexpr int NWAVES = 8;
constexpr int D = 2048, NB = 4, SEQ = 4096, CTXL = 256, DEPTH = 2;
constexpr int ML = NB * SEQ, MC = NB * CTXL, M = ML + MC;
constexpr int DFF = 5632, NFF = 2 * DFF, NMOD = 9 * D;
constexpr int NSRC = 12368, NWIDE = 12288, NIN = 12544;
constexpr int CVW = 2560;
constexpr float EPS = 1e-5f, ALPHA = 1.4142135623730951f;
constexpr int PC_Z = 0, PC_XBC = 1024, PC_MQ = 2560, PC_MV = 3584, PC_MO = 4096, PC_GQ = 4608, PC_GK = 4864, PC_GV = 5120, PC_GR = 5632, PC_GATE = 6144;

constexpr size_t MiB = 1u << 20;
constexpr size_t WS_CTL = 0, CTL_ZERO_BYTES = 1 * MiB;
constexpr size_t WS_MOD = 1 * MiB;
constexpr size_t WS_WB = 2 * MiB;
constexpr size_t WB_FIN = 0, WB_FOUT = WB_FIN + 2 * (size_t)NFF * D * 2, WB_WIN = WB_FOUT + 2 * (size_t)D * DFF * 2, WB_BRS = WB_WIN + (size_t)NIN * D * 2,
                 WB_BRM = WB_BRS + (size_t)D * 1024 * 2, WB_BRG = WB_BRM + (size_t)D * 512 * 2, WB_OUT = WB_BRG + (size_t)D * 512 * 2, WB_END = WB_OUT + (size_t)D * D * 2;
static_assert(WB_END <= 200 * MiB, "weights region");
constexpr size_t WS_H = 202 * MiB;
constexpr size_t WS_U = 338 * MiB;
constexpr size_t WS_Y = 406 * MiB;
constexpr size_t WS_BIG = 474 * MiB;
constexpr size_t WS_PN = 882 * MiB;
constexpr size_t WS_CV = 899 * MiB;
constexpr size_t WS_DT = 984 * MiB;
constexpr size_t WS_DA = WS_DT + (size_t)M * 32 * 4;
constexpr size_t WS_MLG = 989 * MiB;
constexpr size_t WS_DEN = WS_MLG + (size_t)M * 16 * 4;
constexpr size_t WS_GD = 991 * MiB;
constexpr size_t WS_YS = 1025 * MiB;
constexpr size_t WS_YP = 1297 * MiB;
constexpr size_t WS_END = 1329 * MiB;
static_assert(WS_H + (size_t)M * D * 4 <= WS_U && WS_U + (size_t)M * D * 2 <= WS_Y && WS_Y + (size_t)M * D * 2 <= WS_BIG && WS_BIG + (size_t)M * NWIDE * 2 <= WS_PN &&
              WS_PN + (size_t)M * 256 * 4 <= WS_CV && WS_CV + (size_t)M * CVW * 2 <= WS_DT && WS_DA + (size_t)M * 32 * 4 <= WS_MLG && WS_DEN + 2 * (size_t)M * 4 * 4 <= WS_GD &&
              WS_GD + (size_t)M * 512 * 4 <= WS_YS && WS_YS + 2 * (size_t)M * D * 4 <= WS_YP && WS_YP + 4 * (size_t)MC * D * 4 <= WS_END, "d_ws map");
constexpr int CW_BAR = 4096;

constexpr int RING_OFF = 0, RING_BYTES = 131072;
constexpr int LDSCTL_OFF = RING_BYTES, MISC_OFF = LDSCTL_OFF + 320;
constexpr int LDS_BYTES = 147456;

#define GAS __attribute__((address_space(1)))
#define LAS __attribute__((address_space(3)))
typedef unsigned short bf16;
typedef unsigned v4u __attribute__((ext_vector_type(4)));
typedef unsigned v2u __attribute__((ext_vector_type(2)));
typedef float f32x4 __attribute__((ext_vector_type(4)));
#define LDS_WAIT() asm volatile("s_waitcnt lgkmcnt(0)" ::: "memory")
#define VM_WAIT() asm volatile("s_waitcnt vmcnt(0)" ::: "memory")
__device__ __forceinline__ unsigned f2bf(float f) { unsigned u = __builtin_bit_cast(unsigned, f); return (u + 0x7fffu + ((u >> 16) & 1u)) >> 16; }
__device__ __forceinline__ unsigned pk2(float lo, float hi) { unsigned r; asm("v_cvt_pk_bf16_f32 %0, %1, %2" : "=v"(r) : "v"(lo), "v"(hi)); return r; }
__device__ __forceinline__ float bflo(unsigned w) { return __uint_as_float(w << 16); }
__device__ __forceinline__ float bfhi(unsigned w) { return __uint_as_float(w & 0xffff0000u); }
__device__ __forceinline__ float silu_f(float x) { return x / (1.0f + __expf(-x)); }
__device__ __forceinline__ float sigm_f(float x) { return 1.0f / (1.0f + __expf(-x)); }
__device__ __forceinline__ float softplus_f(float x) { return fmaxf(x, 0.f) + log1pf(__expf(-fabsf(x))); }

#define XB_TMO      128
#define XB_XCNT(j)  (256  + 64 * (j))
#define XB_XSUB(j)  (1280 + 64 * (j))
#define XB_XGEN(j)  (2304 + 64 * (j))
#define XB_TOP      3328
#define XB_TOPGEN   3392
#define XCD_BAR_WORDS 3456
#define XB_SPIN_CAP (1u << 18)
__device__ __forceinline__ unsigned xb_ld(unsigned* p)              { return __hip_atomic_load(p, __ATOMIC_RELAXED, __HIP_MEMORY_SCOPE_AGENT); }
__device__ __forceinline__ unsigned xb_add(unsigned* p, unsigned v) { return __hip_atomic_fetch_add(p, v, __ATOMIC_RELAXED, __HIP_MEMORY_SCOPE_AGENT); }
__device__ __forceinline__ unsigned xb_xcc_id() { return (unsigned)__builtin_amdgcn_s_getreg((3 << 11) | 20) & 0xFu; }
#define XB_SPIN(cond, bar) do { unsigned _sp = 0; while (cond) { __builtin_amdgcn_s_sleep(1); \
    if ((++_sp & 255u) == 0u) { if (xb_ld(&(bar)[XB_TMO])) break; if (_sp > XB_SPIN_CAP) { atomicAdd(&(bar)[XB_TMO], 1u); break; } } } } while (0)
struct XcdBarrier { unsigned* bar; unsigned x; volatile LAS unsigned* st; };
__device__ __forceinline__ XcdBarrier xcd_barrier_post(unsigned* bar, volatile LAS unsigned* st) {
    XcdBarrier b; b.bar = bar; b.x = xb_xcc_id(); b.st = st;
    if (threadIdx.x == 0) (void)xb_add(&bar[XB_XCNT(b.x)], 1u);
    return b;
}
__device__ __forceinline__ void xcd_barrier_complete(unsigned* bar, unsigned x, unsigned& nloc, unsigned& nx) {
    const unsigned G = gridDim.x * gridDim.y * gridDim.z;
    unsigned sum, cnt, mine, sp = 0u;
    for (;;) {
        sum = 0u; cnt = 0u; mine = 0u;
#pragma unroll
        for (unsigned j = 0; j < 16; ++j) { const unsigned c = xb_ld(&bar[XB_XCNT(j)]); sum += c; cnt += (c > 0u) ? 1u : 0u; mine = (j == x) ? c : mine; }
        if (sum == G) break;
        __builtin_amdgcn_s_sleep(1);
        if ((++sp & 255u) == 0u) { if (xb_ld(&bar[XB_TMO])) break; if (sp > XB_SPIN_CAP) { atomicAdd(&bar[XB_TMO], 1u); break; } }
    }
    nloc = mine > 0u ? mine : 1u; nx = cnt > 0u ? cnt : 1u;
}
__device__ __forceinline__ void xcd_barrier(const XcdBarrier& b) {
    asm volatile("s_waitcnt vmcnt(0)" ::: "memory");
    __syncthreads();
    if (threadIdx.x == 0) {
        unsigned* bar = b.bar; asm volatile("" : "+s"(bar));
        __builtin_amdgcn_s_waitcnt(0);
        unsigned nloc = b.st[0], nx = b.st[1];
        if (nloc == 0u) { xcd_barrier_complete(bar, b.x, nloc, nx); b.st[0] = nloc; b.st[1] = nx; }
        const unsigned old = xb_add(&bar[XB_XSUB(b.x)], 1u);
        const unsigned gen = old / nloc;
        if (old + 1u == (gen + 1u) * nloc) {
            __builtin_amdgcn_fence(__ATOMIC_RELEASE, "agent");
            asm volatile("s_waitcnt vmcnt(0)" ::: "memory");
            const unsigned og = xb_add(&bar[XB_TOP], 1u);
            const unsigned tg = og / nx;
            if (og + 1u == (tg + 1u) * nx) xb_add(&bar[XB_TOPGEN], 1u);
            else XB_SPIN(xb_ld(&bar[XB_TOPGEN]) == tg, bar);
            __builtin_amdgcn_fence(__ATOMIC_ACQUIRE, "agent");
            xb_add(&bar[XB_XGEN(b.x)], 1u);
            asm volatile("s_waitcnt vmcnt(0)" ::: "memory");
        } else {
            XB_SPIN(xb_ld(&bar[XB_XGEN(b.x)]) == gen, bar);
            __builtin_amdgcn_fence(__ATOMIC_ACQUIRE, "agent");
            asm volatile("s_waitcnt vmcnt(0)" ::: "memory");
        }
    }
    __syncthreads();
}

struct Args { const float* in[29]; float* out; unsigned char* ws; int ph_lo, ph_hi; };
enum { I_X = 0, I_C, I_CTX, I_CCTX, I_WMOD, I_BMOD, I_LNG, I_LNB, I_FWIN, I_FWOUT, I_WIN, I_MERGEB, I_SCW, I_SCB, I_SDTB, I_SALOG, I_SD, I_SNW,
       I_MCW, I_MCB, I_MGB, I_MNW, I_GW2, I_GB2, I_GNW, I_WBS, I_WBM, I_WBG, I_WOUT };
#define CAS __attribute__((address_space(4)))
struct Frame {
    LAS unsigned char* lds;
    int tid, lane, wave, G, gw, NGW;
    const float* const CAS* in; float* out; unsigned char* ws;
};
__device__ __forceinline__ Frame mkframe(LAS unsigned char* lds) {
    Frame F; F.lds = lds;
    int t = threadIdx.x; asm volatile("" : "+v"(t));
    F.tid = t; F.lane = t & 63; F.wave = __builtin_amdgcn_readfirstlane(t >> 6);
    F.G = gridDim.x; F.gw = blockIdx.x * NWAVES + F.wave; F.NGW = F.G * NWAVES;
    const CAS Args* a = (const CAS Args*)__builtin_amdgcn_kernarg_segment_ptr(); asm volatile("" : "+s"(a));
    F.in = a->in; F.out = a->out; F.ws = a->ws;
    return F;
}
__device__ __forceinline__ float wave_sum(float v) {
#pragma unroll
    for (int o = 1; o < 64; o <<= 1) v += __shfl_xor(v, o);
    return v;
}
__device__ __forceinline__ float half_sum(float v) {
#pragma unroll
    for (int o = 1; o < 32; o <<= 1) v += __shfl_xor(v, o);
    return v;
}

__device__ __forceinline__ void tr_item(const float* W, int ldw, int k0, int c0, int ncols, bf16* WT, int ldt, int r0, LAS float* scr, int lane) {
    const int n4 = 4 * (lane & 7);
    f32x4 v[8];
#pragma unroll
    for (int i = 0; i < 8; ++i) { const int kk = 8 * i + (lane >> 3); v[i] = (n4 < ncols) ? *(const GAS f32x4*)(W + (size_t)(k0 + kk) * ldw + c0 + n4) : (f32x4){0.f, 0.f, 0.f, 0.f}; }
#pragma unroll
    for (int i = 0; i < 8; ++i) { const int kk = 8 * i + (lane >> 3); LAS float* d = scr + kk * 33 + n4; d[0] = v[i][0]; d[1] = v[i][1]; d[2] = v[i][2]; d[3] = v[i][3]; }
    LDS_WAIT(); asm volatile("" ::: "memory");
    const int c = lane & 7;
#pragma unroll
    for (int j = 0; j < 4; ++j) { const int n = (lane >> 3) + 8 * j; const LAS float* s = scr + (8 * c) * 33 + n;
        v4u o; o.x = pk2(s[0 * 33], s[1 * 33]); o.y = pk2(s[2 * 33], s[3 * 33]); o.z = pk2(s[4 * 33], s[5 * 33]); o.w = pk2(s[6 * 33], s[7 * 33]);
        *(GAS v4u*)(WT + (size_t)(r0 + n) * ldt + k0 + 8 * c) = o; }
    LDS_WAIT(); asm volatile("" ::: "memory");
}
__device__ __forceinline__ void convert_weights(Frame& F, int l) {
    LAS float* scr = (LAS float*)(F.lds + RING_OFF + F.wave * 16384);
    unsigned char* wb = F.ws + WS_WB;
    constexpr int I_FI = (D / 64) * (NFF / 32), I_FO = (DFF / 64) * (D / 32), I_IN = (D / 64) * (NIN / 32), I_BS = (1024 / 64) * (D / 32), I_BM = (512 / 64) * (D / 32), I_O = (D / 64) * (D / 32);
    constexpr int NITEMS = 2 * I_FI + 2 * I_FO + I_IN + I_BS + 2 * I_BM + I_O;
    for (int it = F.gw; it < NITEMS; it += F.NGW) {
        int r = it;
        if (r < 2 * I_FI) { const int f = r / I_FI; r -= f * I_FI; const int kb = r / (NFF / 32), nb = r % (NFF / 32), c0 = 32 * nb;
            const int r0 = c0 < DFF ? 256 * (c0 / 128) + (c0 % 128) : 256 * ((c0 - DFF) / 128) + 128 + ((c0 - DFF) % 128);
            tr_item(F.in[I_FWIN] + (size_t)(l * 2 + f) * D * NFF, NFF, 64 * kb, c0, 32, (bf16*)(wb + WB_FIN) + (size_t)f * NFF * D, D, r0, scr, F.lane); continue; }
        r -= 2 * I_FI;
        if (r < 2 * I_FO) { const int f = r / I_FO; r -= f * I_FO; const int kb = r / (D / 32), nb = r % (D / 32);
            tr_item(F.in[I_FWOUT] + (size_t)(l * 2 + f) * DFF * D, D, 64 * kb, 32 * nb, 32, (bf16*)(wb + WB_FOUT) + (size_t)f * D * DFF, DFF, 32 * nb, scr, F.lane); continue; }
        r -= 2 * I_FO;
        if (r < I_IN) { const int kb = r / (NIN / 32), db = r % (NIN / 32), r0 = 32 * db; int c0 = 0, nc = 32;
            if (r0 < 2560) c0 = r0; else if (r0 < 4608) c0 = r0 - 2560 + 2592; else if (r0 < 6144) c0 = r0 - 4608 + 4656; else if (r0 < NWIDE) c0 = r0 - 6144 + 6224;
            else if (r0 == NWIDE) c0 = 2560; else if (r0 == NWIDE + 32) c0 = 6192; else if (r0 == NWIDE + 64) { c0 = 4640; nc = 16; } else nc = 0;
            tr_item(F.in[I_WIN] + (size_t)l * D * NSRC, NSRC, 64 * kb, c0, nc, (bf16*)(wb + WB_WIN), D, r0, scr, F.lane); continue; }
        r -= I_IN;
        if (r < I_BS) { const int kb = r / (D / 32), nb = r % (D / 32); tr_item(F.in[I_WBS] + (size_t)l * 1024 * D, D, 64 * kb, 32 * nb, 32, (bf16*)(wb + WB_BRS), D, 32 * nb, scr, F.lane); continue; }
        r -= I_BS;
        if (r < I_BM) { const int kb = r / (D / 32), nb = r % (D / 32); tr_item(F.in[I_WBM] + (size_t)l * 512 * D, D, 64 * kb, 32 * nb, 32, (bf16*)(wb + WB_BRS) + 1024, D, 32 * nb, scr, F.lane); continue; }
        r -= I_BM;
        if (r < I_BM) { const int kb = r / (D / 32), nb = r % (D / 32); tr_item(F.in[I_WBG] + (size_t)l * 512 * D, D, 64 * kb, 32 * nb, 32, (bf16*)(wb + WB_BRS) + 1536, D, 32 * nb, scr, F.lane); continue; }
        r -= I_BM;
        { const int kb = r / (D / 32), nb = r % (D / 32); tr_item(F.in[I_WOUT] + (size_t)l * D * D, D, 64 * kb, 32 * nb, 32, (bf16*)(wb + WB_OUT), D, 32 * nb, scr, F.lane); }
    }
}
__device__ __forceinline__ void mod_phase(Frame& F) {
    LAS float* ss = (LAS float*)(F.lds + RING_OFF);
    LAS float* red = (LAS float*)(F.lds + RING_OFF + 40960);
    float* MOD = (float*)(F.ws + WS_MOD);
    __syncthreads();
    for (int i = F.tid; i < 5 * D; i += NWAVES * 64) { const int b = i / D, k = i % D; const float v = b < NB ? F.in[I_C][b * D + k] : F.in[I_CCTX][k]; ss[i] = silu_f(v); }
    __syncthreads();
    const int half = F.lane >> 5, cl = F.lane & 31;
    for (int unit = blockIdx.x; unit < 2 * (NMOD / 128); unit += F.G) {
        const int l = unit / (NMOD / 128), col0 = (unit % (NMOD / 128)) * 128;
        const float* wp = F.in[I_WMOD] + (size_t)l * D * NMOD + col0 + 4 * cl;
        f32x4 a0 = {0.f, 0.f, 0.f, 0.f}, a1 = a0, a2 = a0, a3 = a0, a4 = a0;
#pragma unroll 8
        for (int i = 0; i < 128; ++i) { const int k = 256 * F.wave + 2 * i + half; const f32x4 wv = *(const GAS f32x4*)(wp + (size_t)k * NMOD);
            a0 += ss[k] * wv; a1 += ss[D + k] * wv; a2 += ss[2 * D + k] * wv; a3 += ss[3 * D + k] * wv; a4 += ss[4 * D + k] * wv; }
#pragma unroll
        for (int j = 0; j < 4; ++j) { a0[j] += __shfl_xor(a0[j], 32); a1[j] += __shfl_xor(a1[j], 32); a2[j] += __shfl_xor(a2[j], 32); a3[j] += __shfl_xor(a3[j], 32); a4[j] += __shfl_xor(a4[j], 32); }
        if (F.lane < 32) { LAS f32x4* rp = (LAS f32x4*)(red + F.wave * 640) + cl; rp[0] = a0; rp[32] = a1; rp[64] = a2; rp[96] = a3; rp[128] = a4; }
        __syncthreads();
        for (int o = F.tid; o < 640; o += NWAVES * 64) { const int b = o / 128, cc = o % 128; float s = F.in[I_BMOD][l * NMOD + col0 + cc];
#pragma unroll
            for (int w = 0; w < 8; ++w) s += red[w * 640 + o];
            MOD[(size_t)(l * 5 + b) * NMOD + col0 + cc] = s; }
        __syncthreads();
    }
}
__device__ __forceinline__ void modulate_rows(Frame& F, int l, int k, int rows) {
    const float* MOD = (const float*)(F.ws + WS_MOD); bf16* U = (bf16*)(F.ws + WS_U);
    for (int rr = F.gw; rr < rows; rr += 2 * F.NGW) {
        f32x4 u[2][8];
#pragma unroll
        for (int q = 0; q < 2; ++q) { const int r0 = rr + q * F.NGW, r = r0 < rows ? r0 : rr; const int b = r < ML ? r / SEQ : NB;
            const float* hp = r < ML ? F.in[I_X] + (size_t)r * D : F.in[I_CTX] + (size_t)(r - ML) * D;
            const float* mA = MOD + (size_t)(l * 5 + b) * NMOD + (3 * k + 1) * D; const float* mB = MOD + (size_t)(l * 5 + b) * NMOD + (3 * k) * D;
#pragma unroll
            for (int j = 0; j < 8; ++j) { const int c = 4 * F.lane + 256 * j; const f32x4 h = *(const GAS f32x4*)(hp + c), a = *(const GAS f32x4*)(mA + c), bb = *(const GAS f32x4*)(mB + c); u[q][j] = h * (1.0f + a) + bb; } }
#pragma unroll
        for (int q = 0; q < 2; ++q) { const int r = rr + q * F.NGW; if (r >= rows) continue;
#pragma unroll
            for (int j = 0; j < 8; ++j) { const int c = 4 * F.lane + 256 * j; v2u w; w.x = pk2(u[q][j][0], u[q][j][1]); w.y = pk2(u[q][j][2], u[q][j][3]); *(GAS v2u*)(U + (size_t)r * D + c) = w; } }
    }
}
struct LnArgs { int l, k, ln_idx, lnx, kn; float gate_scale; bool hin_input, write_u, final_out, dummy; };
template <int NR, bool PARTS> __device__ __forceinline__ void ln_span(Frame& F, const LnArgs a, int rlo, int rhi) {
    const float* YP = (const float*)(F.ws + WS_YP);
    const float* MOD = (const float*)(F.ws + WS_MOD); bf16* U = (bf16*)(F.ws + (a.dummy ? WS_YS + 136 * MiB : WS_U)); const bf16* Y = (const bf16*)(F.ws + WS_Y); const float* H = (const float*)(F.ws + WS_H); float* HO = (float*)(F.ws + (a.dummy ? WS_YS : WS_H));
    const float* lg = F.in[I_LNG] + (size_t)(a.l * 3 + a.ln_idx) * D; const float* lb = F.in[I_LNB] + (size_t)(a.l * 3 + a.ln_idx) * D;
    for (int rr = rlo + F.gw; rr < rhi; rr += NR * F.NGW) {
        f32x4 t[NR][8]; float s[NR]; int rw[NR], bw[NR];
#pragma unroll
        for (int q = 0; q < NR; ++q) { s[q] = 0.f; const int r = rr + q * F.NGW; rw[q] = r; const int rc = r < rhi ? r : rr; const int b = rc < ML ? rc / SEQ : NB; bw[q] = b;
            const float* hp = a.hin_input ? (rc < ML ? F.in[I_X] + (size_t)rc * D : F.in[I_CTX] + (size_t)(rc - ML) * D) : H + (size_t)rc * D;
            const float* mg = MOD + (size_t)(a.l * 5 + b) * NMOD + (3 * a.k + 2) * D;
#pragma unroll
            for (int j = 0; j < 8; ++j) { const int c = 4 * F.lane + 256 * j; const f32x4 h = *(const GAS f32x4*)(hp + c), g = *(const GAS f32x4*)(mg + c);
                f32x4 y;
                if (PARTS) { const float* yp = YP + (size_t)(rc - ML) * D + c; y = (*(const GAS f32x4*)yp + *(const GAS f32x4*)(yp + (size_t)MC * D)) + (*(const GAS f32x4*)(yp + 2 * (size_t)MC * D) + *(const GAS f32x4*)(yp + 3 * (size_t)MC * D)); }
                else { const v2u yw = *(const GAS v2u*)(Y + (size_t)rc * D + c); y[0] = bflo(yw.x); y[1] = bfhi(yw.x); y[2] = bflo(yw.y); y[3] = bfhi(yw.y); }
                t[q][j] = ALPHA * h + (a.gate_scale * g) * y; s[q] += (t[q][j][0] + t[q][j][1]) + (t[q][j][2] + t[q][j][3]); } }
#pragma unroll
        for (int q = 0; q < NR; ++q) { const int r = rw[q]; if (r >= rhi) continue; const int b = bw[q];
            const float mean = wave_sum(s[q]) * (1.f / D); float s2 = 0.f;
#pragma unroll
            for (int j = 0; j < 8; ++j) { t[q][j] = t[q][j] - mean; s2 += (t[q][j][0] * t[q][j][0] + t[q][j][1] * t[q][j][1]) + (t[q][j][2] * t[q][j][2] + t[q][j][3] * t[q][j][3]); }
            const float rstd = 1.f / sqrtf(wave_sum(s2) * (1.f / D) + EPS);
            const float* mA = MOD + (size_t)(a.lnx * 5 + b) * NMOD + (3 * a.kn + 1) * D; const float* mB = MOD + (size_t)(a.lnx * 5 + b) * NMOD + (3 * a.kn) * D;
#pragma unroll
            for (int j = 0; j < 8; ++j) { const int c = 4 * F.lane + 256 * j; const f32x4 g = *(const GAS f32x4*)(lg + c), be = *(const GAS f32x4*)(lb + c);
                const f32x4 o = t[q][j] * rstd * g + be;
                if (a.final_out && !a.dummy) { if (r < ML) *(GAS f32x4*)(F.out + (size_t)r * D + c) = o; }
                else *(GAS f32x4*)(HO + (size_t)r * D + c) = o;
                if (a.write_u) { const f32x4 av = *(const GAS f32x4*)(mA + c), bb = *(const GAS f32x4*)(mB + c); const f32x4 u = o * (1.0f + av) + bb;
                    v2u w; w.x = pk2(u[0], u[1]); w.y = pk2(u[2], u[3]); *(GAS v2u*)(U + (size_t)r * D + c) = w; } } }
    }
}
__device__ __forceinline__ void ln_rows(Frame& F, int l, int k, float gate_scale, bool hin_input, int ln_idx, int lnx, int kn, bool write_u, bool final_out, int rows, bool dummy = false, bool ctx_parts = false) {
    const LnArgs a{l, k, ln_idx, lnx, kn, gate_scale, hin_input, write_u, final_out, dummy};
    ln_span<2, false>(F, a, 0, rows < ML ? rows : ML);
    if (rows > ML) { if (ctx_parts) ln_span<1, true>(F, a, ML, rows); else ln_span<1, false>(F, a, ML, rows); }
}
__device__ __forceinline__ void prep_phase(Frame& F, int l, int mode = 3) {
    const bf16* P = (const bf16*)(F.ws + WS_BIG); bf16* CV = (bf16*)(F.ws + WS_CV); const float* PN = (const float*)(F.ws + WS_PN);
    const int gt = blockIdx.x * (NWAVES * 64) + F.tid, NT = F.G * NWAVES * 64;
    if (mode & 1) {
        constexpr int NCG = CVW / 8;
        const int nx = (F.G % 8 == 0) ? 8 : 1, wpx = F.G / nx, xcd = (int)blockIdx.x % nx, wix = (int)blockIdx.x / nx;
        const int RS = (wpx * NWAVES * 64) / NCG;
        const int lt = wix * (NWAVES * 64) + F.tid, cg = lt % NCG, ch0 = cg * 8;
        const int rows_x = (M + nx - 1) / nx, rlo = xcd * rows_x, rhi = (rlo + rows_x < M) ? rlo + rows_x : M;
        const int rbeg = rlo + lt / NCG;
        if (lt / NCG < RS) {
            const float* w9; const float* bs; int wst;
            if (ch0 < 1536) { w9 = F.in[I_SCW] + (size_t)l * 9 * 1536 + ch0; bs = F.in[I_SCB] + l * 1536 + ch0; wst = 1536; }
            else { w9 = F.in[I_MCW] + (size_t)l * 9 * 1024 + (ch0 - 1536); bs = F.in[I_MCB] + l * 1024 + (ch0 - 1536); wst = 1024; }
            f32x4 wa[9], wb[9];
#pragma unroll
            for (int t9 = 0; t9 < 9; ++t9) { wa[t9] = *(const GAS f32x4*)(w9 + t9 * wst); wb[t9] = *(const GAS f32x4*)(w9 + t9 * wst + 4); }
            const f32x4 b0 = *(const GAS f32x4*)bs, b1 = *(const GAS f32x4*)(bs + 4);
            for (int rr = rbeg; rr < rhi; rr += 2 * RS) {
                v4u xv[2][9]; bool ok[2][9];
#pragma unroll
                for (int q = 0; q < 2; ++q) { const int r0_ = rr + q * RS, r = r0_ < rhi ? r0_ : rr;
                    const bf16* pin = P + (size_t)r * NWIDE + PC_XBC + ch0;
                    if (r < ML) { const int t = r % SEQ, gr = t >> 6, gc = t & 63;
#pragma unroll
                        for (int dr = -1; dr <= 1; ++dr)
#pragma unroll
                            for (int dc = -1; dc <= 1; ++dc) { const int i9 = (dr + 1) * 3 + (dc + 1); const bool v = !(gr + dr < 0 || gr + dr > 63 || gc + dc < 0 || gc + dc > 63); ok[q][i9] = v;
                                xv[q][i9] = v ? *(const GAS v4u*)(pin + (ptrdiff_t)(dr * 64 + dc) * NWIDE) : (v4u){0u, 0u, 0u, 0u}; }
                    } else { const int t = (r - ML) % CTXL;
#pragma unroll
                        for (int i9 = 0; i9 < 9; ++i9) { const int dc = i9 % 3 - 1; const bool v = (i9 / 3 == 1) && !(t + dc < 0 || t + dc >= CTXL); ok[q][i9] = v;
                            xv[q][i9] = v ? *(const GAS v4u*)(pin + (ptrdiff_t)dc * NWIDE) : (v4u){0u, 0u, 0u, 0u}; } }
                }
#pragma unroll
                for (int q = 0; q < 2; ++q) { const int r = rr + q * RS; if (r >= rhi) continue;
                    f32x4 a0 = b0, a1 = b1;
#pragma unroll
                    for (int i9 = 0; i9 < 9; ++i9) { const v4u x = xv[q][i9]; const f32x4 w0 = wa[i9], w1 = wb[i9];
                        a0[0] += bflo(x.x) * w0[0]; a0[1] += bfhi(x.x) * w0[1]; a0[2] += bflo(x.y) * w0[2]; a0[3] += bfhi(x.y) * w0[3];
                        a1[0] += bflo(x.z) * w1[0]; a1[1] += bfhi(x.z) * w1[1]; a1[2] += bflo(x.w) * w1[2]; a1[3] += bfhi(x.w) * w1[3]; }
                    v4u o; o.x = pk2(silu_f(a0[0]), silu_f(a0[1])); o.y = pk2(silu_f(a0[2]), silu_f(a0[3])); o.z = pk2(silu_f(a1[0]), silu_f(a1[1])); o.w = pk2(silu_f(a1[2]), silu_f(a1[3]));
                    *(GAS v4u*)(CV + (size_t)r * CVW + ch0) = o; }
            }
        }
    }
    float* DT = (float*)(F.ws + WS_DT); float* DA = (float*)(F.ws + WS_DA); float* MLG = (float*)(F.ws + WS_MLG); float* GD = (float*)(F.ws + WS_GD);
    if (mode & 2) {
        const int c = F.tid, d = c >> 8, j = c & 255;
        const float* w2 = F.in[I_GW2] + (size_t)(l * 2 + d) * 16 * 256 + j; const float b2 = F.in[I_GB2][(l * 2 + d) * 256 + j];
        float w2r[16];
#pragma unroll
        for (int q = 0; q < 16; ++q) w2r[q] = w2[q * 256];
        const float cb = c < 32 ? F.in[I_SDTB][l * 32 + c] : (c < 48 ? F.in[I_MGB][l * 16 + (c - 32)] : 0.f);
        const int pc = c < 32 ? c : (c < 48 ? 64 + (c - 32) : 0);
        int r = blockIdx.x;
        f32x4 n0, n1, n2, n3; float ns = 0.f;
        if (r < M) { const float* pn = PN + (size_t)r * 256; n0 = *(const GAS f32x4*)(pn + 32 + d * 16); n1 = *(const GAS f32x4*)(pn + 36 + d * 16); n2 = *(const GAS f32x4*)(pn + 40 + d * 16); n3 = *(const GAS f32x4*)(pn + 44 + d * 16); ns = pn[pc]; }
        for (; r < M; r += F.G) {
            const f32x4 l0 = n0, l1 = n1, l2 = n2, l3 = n3; const float sv = ns;
            const int rn = r + F.G;
            if (rn < M) { const float* pn = PN + (size_t)rn * 256; n0 = *(const GAS f32x4*)(pn + 32 + d * 16); n1 = *(const GAS f32x4*)(pn + 36 + d * 16); n2 = *(const GAS f32x4*)(pn + 40 + d * 16); n3 = *(const GAS f32x4*)(pn + 44 + d * 16); ns = pn[pc]; }
            float z = b2;
#pragma unroll
            for (int q = 0; q < 4; ++q) { z += l0[q] * w2r[q]; z += l1[q] * w2r[4 + q]; z += l2[q] * w2r[8 + q]; z += l3[q] * w2r[12 + q]; }
            const float ls = fminf(z, 0.f) - __logf(1.0f + __expf(-fabsf(z)));
            GD[(size_t)r * 512 + c] = ls * (1.0f / 16.0f);
            if (c < 32) DT[(size_t)r * 32 + c] = softplus_f(sv + cb);
            else if (c < 48) { const int i = c - 32; const float g = sv + cb;
                MLG[(size_t)r * 16 + i] = ((i >> 2) & 1) ? (fminf(g, 0.f) - log1pf(__expf(-fabsf(g)))) : g; }
        }
    }
}
#define LBAR() do { asm volatile("s_waitcnt lgkmcnt(0)" ::: "memory"); __builtin_amdgcn_s_barrier(); asm volatile("" ::: "memory"); } while (0)
typedef float f32x16 __attribute__((ext_vector_type(16)));
typedef short bf16x8v __attribute__((ext_vector_type(8)));
__device__ __forceinline__ void unpack8(const v4u w, float (&o)[8]) { o[0] = bflo(w.x); o[1] = bfhi(w.x); o[2] = bflo(w.y); o[3] = bfhi(w.y); o[4] = bflo(w.z); o[5] = bfhi(w.z); o[6] = bflo(w.w); o[7] = bfhi(w.w); }
template <int KS> __device__ __forceinline__ void mma_tile(f32x16& acc, const LAS unsigned char* A, int sa, int rA, const LAS unsigned char* B, int sb, int rB, int r, int h) {
    const LAS unsigned char* ap = A + (rA + r) * sa + 16 * h; const LAS unsigned char* bp = B + (rB + r) * sb + 16 * h;
#pragma unroll
    for (int s0 = 0; s0 < KS; s0 += 4) {
        bf16x8v a[4], b[4];
#pragma unroll
        for (int s = 0; s < 4; ++s) if (s0 + s < KS) { a[s] = *(const LAS bf16x8v*)(ap + 32 * (s0 + s)); b[s] = *(const LAS bf16x8v*)(bp + 32 * (s0 + s)); }
        __builtin_amdgcn_sched_barrier(0);
#pragma unroll
        for (int s = 0; s < 4; ++s) if (s0 + s < KS) acc = __builtin_amdgcn_mfma_f32_32x32x16_bf16(a[s], b[s], acc, 0, 0, 0);
    }
}
__device__ __forceinline__ void store_tile_T(const f32x16& acc, LAS unsigned char* img, int stride, int row0, int k0, int r, int h) {
#pragma unroll
    for (int g = 0; g < 4; ++g) { v2u w; w.x = pk2(acc[4 * g], acc[4 * g + 1]); w.y = pk2(acc[4 * g + 2], acc[4 * g + 3]);
        *(LAS v2u*)(img + (row0 + r) * stride + (k0 + 8 * g + 4 * h) * 2) = w; }
}
__device__ __forceinline__ float wave_incl_scan(float v, int lane) {
#pragma unroll
    for (int o = 1; o < 64; o <<= 1) { const float t = __shfl_up(v, o); if (lane >= o) v += t; }
    return v;
}
__device__ __forceinline__ float half_incl_scan_dpp(float v) {
    int x = __builtin_bit_cast(int, v);
#define HS_STEP(CTRL, RM) do { const int t_ = __builtin_amdgcn_update_dpp(0, x, (CTRL), (RM), 0xf, false); x = __builtin_bit_cast(int, __builtin_bit_cast(float, x) + __builtin_bit_cast(float, t_)); } while (0)
    HS_STEP(0x111, 0xf); HS_STEP(0x112, 0xf); HS_STEP(0x114, 0xf); HS_STEP(0x118, 0xf);
    HS_STEP(0x142, 0xa);
#undef HS_STEP
    return __builtin_bit_cast(float, x);
}
__device__ __forceinline__ int scan_chunk_row0(int b, int d, int c) {
    if (c < CTXL / 64) return ML + b * CTXL + 64 * (d ? CTXL / 64 - 1 - c : c);
    const int lc = c - CTXL / 64; return b * SEQ + 64 * (d ? SEQ / 64 - 1 - lc : lc);
}
template <int KIND, int DRY = 0> __device__ __forceinline__ void scan_chunked(Frame& F, int l, int task) {
    constexpr int DK = KIND == 1 ? 128 : 64, NVT = KIND == 1 ? 3 : 2, DVR = 64, NKT = DK / 32;
    constexpr int NST = NKT * NVT, NOT = 2 * NVT, ST_PW = (NST + 7) / 8, OT_PW = (NOT + 7) / 8;
    constexpr int SQ = (DK + 8) * 2, SJ = 144;
    constexpr int O_QA = 0, O_KA = O_QA + 64 * SQ, O_VT = O_KA + 64 * SQ, O_KET = O_VT + NVT * 32 * SJ, O_AIM = O_KET + DK * SJ, O_STI = O_AIM + 64 * SJ, O_TAB = O_STI + NVT * 32 * SQ;
    constexpr int TABF = 64 * 6;
    static_assert(O_TAB + 2 * TABF * 4 <= RING_BYTES, "scan LDS");
    LAS unsigned char* L = F.lds;
    int tid_ = F.tid; asm volatile("" : "+v"(tid_));
    const int tid = tid_, lane = tid & 63, w = __builtin_amdgcn_readfirstlane(tid >> 6), r = lane & 31, h = lane >> 5;
    int b, d, hd; int vh = 0;
    if (KIND == 0) { b = task >> 5; d = (task >> 4) & 1; hd = task & 15; } else { b = task >> 4; d = (task >> 3) & 1; hd = (task >> 1) & 3; vh = task & 1; }
    const bf16* CV = (const bf16*)(F.ws + WS_CV); const bf16* P = (const bf16*)(F.ws + WS_BIG);
    bf16* YS = (bf16*)(F.ws + WS_YS) + (size_t)d * M * D; float* DEN = (float*)(F.ws + WS_DEN) + (size_t)d * M * 4;
    const bf16 *qsrc, *ksrc, *vsrc; int qpitch, vpitch, ycol;
    if (KIND == 0) { qsrc = CV + 1280 + (hd >> 2) * 64; ksrc = CV + 1024 + (hd >> 2) * 64; vsrc = CV + hd * 64; qpitch = CVW; vpitch = CVW; ycol = hd * 64; }
    else if (KIND == 1) { qsrc = CV + 1536 + hd * 128; ksrc = CV + 2048 + hd * 128; vsrc = P + PC_MV + hd * 128 + vh * 64; qpitch = CVW; vpitch = NWIDE; ycol = 1024 + hd * 128 + vh * 64; }
    else { qsrc = P + PC_GQ + hd * 64; ksrc = P + PC_GK + hd * 64; vsrc = P + PC_GV + hd * 128 + vh * 64; qpitch = NWIDE; vpitch = NWIDE; ycol = 1536 + hd * 128 + vh * 64; }
    const float* sc1; float aneg = 0.f;
    if (KIND == 0) { sc1 = (const float*)(F.ws + WS_DT) + d * 16 + hd; aneg = -__expf(F.in[I_SALOG][l * 32 + d * 16 + hd]); }
    else sc1 = (const float*)(F.ws + WS_MLG) + d * 8 + hd;
    const float* gdsrc = (const float*)(F.ws + WS_GD) + d * 256 + hd * 64;
    const int pr = tid & 31, grp = tid >> 5;
    const bool isq = (DK == 128) || grp < 8;
    const int qkg = (DK == 128) ? grp : (grp & 7);
    const bool hasv = (DVR == 128) || grp < 8;
    constexpr int TW = 7;
    int sti[ST_PW], oti[OT_PW];
#pragma unroll
    for (int s = 0; s < ST_PW; ++s) { const int i = (KIND != 1) ? (w >= 4 ? w - 4 : NST) : (w + 8 * s); sti[s] = (i < NST) ? i : -1; }
#pragma unroll
    for (int s = 0; s < OT_PW; ++s) { const int i = (KIND != 1) ? (w < 4 ? w : NOT) : (w + 8 * s); oti[s] = (i < NOT) ? i : -1; }
    const int p1i = (KIND == 1) ? (w >= 4 ? w - 4 : -1) : (w < 4 ? w : -1);
    f32x16 st[ST_PW];
#pragma unroll
    for (int s = 0; s < ST_PW; ++s)
#pragma unroll
        for (int i = 0; i < 16; ++i) st[s][i] = 0.f;
    for (int i = tid; i < NVT * 32 * SQ / 4; i += NWAVES * 64) ((LAS unsigned*)(L + O_STI))[i] = 0u;
    if (KIND == 1) for (int i = tid; i < 32 * SJ / 4; i += NWAVES * 64) ((LAS unsigned*)(L + O_VT + 64 * SJ))[i] = (i < SJ / 4) ? 0x3f803f80u : 0u;
    v4u rq[2], rk[2], rv[2]; float rs1 = 0.f, rs2 = 0.f; f32x4 rg[4];
    constexpr int NCH = (CTXL + SEQ) / 64;
    f32x16 ohold[OT_PW]; int orow0 = 0;
#define SCAN_STORE_OUT() do { _Pragma("unroll") for (int s = 0; s < OT_PW; ++s) if (oti[s] >= 0) { const int tt = oti[s] & 1, vt = oti[s] >> 1; \
        _Pragma("unroll") for (int i = 0; i < 16; ++i) { const int t = 32 * tt + (i & 3) + 8 * (i >> 2) + 4 * h; \
            if (KIND == 1 && vt == 2) { if (r == 0 && vh == 0) DEN[(size_t)(orow0 + t) * 4 + hd] = ohold[s][i]; } \
            else YS[(size_t)(orow0 + t) * D + ycol + 32 * vt + r] = (bf16)f2bf(ohold[s][i]); } } } while (0)
#define SCAN_PREFETCH(ROW0) do { const size_t r0_ = (size_t)((ROW0) + 2 * pr), r1_ = r0_ + 1; \
        if (DK == 128) { rq[0] = *(const GAS v4u*)(qsrc + r0_ * qpitch + 8 * qkg); rq[1] = *(const GAS v4u*)(qsrc + r1_ * qpitch + 8 * qkg); rk[0] = *(const GAS v4u*)(ksrc + r0_ * qpitch + 8 * qkg); rk[1] = *(const GAS v4u*)(ksrc + r1_ * qpitch + 8 * qkg); } \
        else { const bf16* sp_ = isq ? qsrc : ksrc; rq[0] = *(const GAS v4u*)(sp_ + r0_ * qpitch + 8 * qkg); rq[1] = *(const GAS v4u*)(sp_ + r1_ * qpitch + 8 * qkg); } \
        if (hasv) { rv[0] = *(const GAS v4u*)(vsrc + r0_ * vpitch + 8 * grp); rv[1] = *(const GAS v4u*)(vsrc + r1_ * vpitch + 8 * grp); } \
        if (KIND != 2) { if (w == TW) { rs1 = sc1[(size_t)((ROW0) + lane) * (KIND == 0 ? 32 : 16)]; if (KIND == 1) rs2 = sc1[(size_t)((ROW0) + lane) * 16 + 4]; } } \
        else { rg[0] = *(const GAS f32x4*)(gdsrc + r0_ * 512 + 8 * qkg); rg[1] = *(const GAS f32x4*)(gdsrc + r0_ * 512 + 8 * qkg + 4); rg[2] = *(const GAS f32x4*)(gdsrc + r1_ * 512 + 8 * qkg); rg[3] = *(const GAS f32x4*)(gdsrc + r1_ * 512 + 8 * qkg + 4); } \
    } while (0)
#define SCAN_TABLES(SET) do { constexpr float L2E = 1.4426950408889634f; LAS float* T_ = (LAS float*)(L + O_TAB) + (SET) * TABF; \
        const float lg_ = (KIND == 0) ? rs1 * aneg : rs2; const float inc_ = wave_incl_scan(lg_, lane), tot_ = __shfl(inc_, 63); \
        const float cs_ = d ? (tot_ - inc_ + lg_) : inc_; const float ii_ = (KIND == 1) ? rs1 : 0.f; \
        T_[lane] = cs_ * L2E; T_[64 + lane] = (cs_ - ii_) * L2E; T_[128 + lane] = (KIND == 0) ? rs1 : 1.f; \
        T_[192 + lane] = __expf(cs_); T_[256 + lane] = __expf(tot_ - cs_ + ii_) * ((KIND == 0) ? rs1 : 1.f); if (lane == 0) T_[320] = __expf(tot_); } while (0)
    SCAN_PREFETCH(scan_chunk_row0(b, d, 0));
    if (KIND != 2 && w == TW) SCAN_TABLES(0);
    LBAR();
    for (int c = 0; c < NCH; ++c) {
        const int row0 = scan_chunk_row0(b, d, c);
        LAS float* T1 = (LAS float*)(L + O_TAB) + (KIND == 2 ? 0 : (c & 1) * TABF); LAS float* T2 = T1 + 64; LAS float* T3 = T2 + 64; LAS float* ET = T3 + 64; LAS float* EJ = ET + 64; LAS float* DEC = EJ + 64;
        if (DRY != 2) {
            const int t0 = 2 * pr, t1 = t0 + 1;
            float a0[8], a1[8];
            if (DK == 128) {
                unpack8(rq[0], a0); unpack8(rq[1], a1); const float qs = 0.08838834764831845f;
                v4u o0, o1; o0.x = pk2(a0[0] * qs, a0[1] * qs); o0.y = pk2(a0[2] * qs, a0[3] * qs); o0.z = pk2(a0[4] * qs, a0[5] * qs); o0.w = pk2(a0[6] * qs, a0[7] * qs);
                o1.x = pk2(a1[0] * qs, a1[1] * qs); o1.y = pk2(a1[2] * qs, a1[3] * qs); o1.z = pk2(a1[4] * qs, a1[5] * qs); o1.w = pk2(a1[6] * qs, a1[7] * qs);
                *(LAS v4u*)(L + O_QA + t0 * SQ + 16 * qkg) = o0; *(LAS v4u*)(L + O_QA + t1 * SQ + 16 * qkg) = o1;
                *(LAS v4u*)(L + O_KA + t0 * SQ + 16 * qkg) = rk[0]; *(LAS v4u*)(L + O_KA + t1 * SQ + 16 * qkg) = rk[1];
                unpack8(rk[0], a0); unpack8(rk[1], a1); const float e0 = EJ[t0], e1 = EJ[t1];
#pragma unroll
                for (int e = 0; e < 8; ++e) *(LAS unsigned*)(L + O_KET + (8 * qkg + e) * SJ + 4 * pr) = pk2(a0[e] * e0, a1[e] * e1);
            } else if (KIND == 0) {
                if (isq) { *(LAS v4u*)(L + O_QA + t0 * SQ + 16 * qkg) = rq[0]; *(LAS v4u*)(L + O_QA + t1 * SQ + 16 * qkg) = rq[1]; }
                else { *(LAS v4u*)(L + O_KA + t0 * SQ + 16 * qkg) = rq[0]; *(LAS v4u*)(L + O_KA + t1 * SQ + 16 * qkg) = rq[1];
                    unpack8(rq[0], a0); unpack8(rq[1], a1); const float e0 = EJ[t0], e1 = EJ[t1];
#pragma unroll
                    for (int e = 0; e < 8; ++e) *(LAS unsigned*)(L + O_KET + (8 * qkg + e) * SJ + 4 * pr) = pk2(a0[e] * e0, a1[e] * e1); }
            } else {
                float la0[8], la1[8], c0[8], c1[8], tot[8];
#pragma unroll
                for (int e = 0; e < 4; ++e) { la0[e] = rg[0][e]; la0[4 + e] = rg[1][e]; la1[e] = rg[2][e]; la1[4 + e] = rg[3][e]; }
#pragma unroll
                for (int e = 0; e < 8; ++e) { const float sp = la0[e] + la1[e]; const float inc = half_incl_scan_dpp(sp);
                    tot[e] = __shfl(inc, 31, 32);
                    if (!d) { c1[e] = inc; c0[e] = inc - la1[e]; } else { const float suf = tot[e] - inc + sp; c0[e] = suf; c1[e] = suf - la0[e]; } }
                unpack8(rq[0], a0); unpack8(rq[1], a1);
                if (isq) { float q0[8], q1[8];
#pragma unroll
                    for (int e = 0; e < 8; ++e) { q0[e] = a0[e] * 0.125f * __expf(c0[e]); q1[e] = a1[e] * 0.125f * __expf(c1[e]); }
                    v4u o0, o1; o0.x = pk2(q0[0], q0[1]); o0.y = pk2(q0[2], q0[3]); o0.z = pk2(q0[4], q0[5]); o0.w = pk2(q0[6], q0[7]); o1.x = pk2(q1[0], q1[1]); o1.y = pk2(q1[2], q1[3]); o1.z = pk2(q1[4], q1[5]); o1.w = pk2(q1[6], q1[7]);
                    *(LAS v4u*)(L + O_QA + t0 * SQ + 16 * qkg) = o0; *(LAS v4u*)(L + O_QA + t1 * SQ + 16 * qkg) = o1;
                } else { float k0[8], k1[8];
#pragma unroll
                    for (int e = 0; e < 8; ++e) { k0[e] = a0[e] * __expf(-c0[e]); k1[e] = a1[e] * __expf(-c1[e]); }
                    v4u o0, o1; o0.x = pk2(k0[0], k0[1]); o0.y = pk2(k0[2], k0[3]); o0.z = pk2(k0[4], k0[5]); o0.w = pk2(k0[6], k0[7]); o1.x = pk2(k1[0], k1[1]); o1.y = pk2(k1[2], k1[3]); o1.z = pk2(k1[4], k1[5]); o1.w = pk2(k1[6], k1[7]);
                    *(LAS v4u*)(L + O_KA + t0 * SQ + 16 * qkg) = o0; *(LAS v4u*)(L + O_KA + t1 * SQ + 16 * qkg) = o1;
#pragma unroll
                    for (int e = 0; e < 8; ++e) *(LAS unsigned*)(L + O_KET + (8 * qkg + e) * SJ + 4 * pr) = pk2(a0[e] * __expf(tot[e] - c0[e]), a1[e] * __expf(tot[e] - c1[e]));
                    if (pr == 0) {
#pragma unroll
                        for (int e = 0; e < 8; ++e) DEC[8 * qkg + e] = __expf(tot[e]); } }
            }
            if (hasv) { unpack8(rv[0], a0); unpack8(rv[1], a1);
#pragma unroll
                for (int e = 0; e < 8; ++e) *(LAS unsigned*)(L + O_VT + (8 * grp + e) * SJ + 4 * pr) = pk2(a0[e], a1[e]); }
        }
        if (DRY == 2) { asm volatile("" :: "v"(rq[0]), "v"(rq[1]), "v"(rv[0]), "v"(rv[1])); if (DK == 128) asm volatile("" :: "v"(rk[0]), "v"(rk[1])); if (KIND == 2) asm volatile("" :: "v"(rg[0]), "v"(rg[1]), "v"(rg[2]), "v"(rg[3])); }
        if (c + 1 < NCH) SCAN_PREFETCH(scan_chunk_row0(b, d, c + 1));
        if (c > 0 && DRY == 0) SCAN_STORE_OUT();
        LBAR();
#pragma unroll
        for (int s = 0; s < ST_PW; ++s) if (DRY != 1 && sti[s] >= 0) { const int kt = sti[s] % NKT, vt = sti[s] / NKT;
            if (KIND == 2) {
#pragma unroll
                for (int g = 0; g < 4; ++g) { const f32x4 dv = *(const LAS f32x4*)(DEC + 32 * kt + 8 * g + 4 * h);
#pragma unroll
                    for (int e = 0; e < 4; ++e) st[s][4 * g + e] *= dv[e]; }
            } else { const float dv = DEC[0];
#pragma unroll
                for (int i = 0; i < 16; ++i) st[s][i] *= dv; }
            mma_tile<4>(st[s], L + O_KET, SJ, 32 * kt, L + O_VT, SJ, 32 * vt, r, h); }
        if (DRY != 1 && p1i >= 0) { const int jt = p1i & 1, tt = p1i >> 1;
            f32x16 a;
#pragma unroll
            for (int i = 0; i < 16; ++i) a[i] = 0.f;
            mma_tile<DK / 16>(a, L + O_KA, SQ, 32 * jt, L + O_QA, SQ, 32 * tt, r, h);
            const int t = 32 * tt + r; const float t1v = (KIND == 2) ? 0.f : T1[t];
#pragma unroll
            for (int g = 0; g < 4; ++g) { const int jb = 32 * jt + 8 * g + 4 * h;
                f32x4 t2 = {0.f, 0.f, 0.f, 0.f}, t3 = {1.f, 1.f, 1.f, 1.f};
                if (KIND != 2) { t2 = *(const LAS f32x4*)(T2 + jb); if (KIND == 0) t3 = *(const LAS f32x4*)(T3 + jb); }
#pragma unroll
                for (int e = 0; e < 4; ++e) { const int j = jb + e; const bool keep = d ? (j >= t) : (j <= t);
                    const float wv = (KIND == 2) ? 1.f : __builtin_amdgcn_exp2f(t1v - t2[e]) * t3[e];
                    a[4 * g + e] = keep ? a[4 * g + e] * wv : 0.f; } }
            store_tile_T(a, L + O_AIM, SJ, 32 * tt, 32 * jt, r, h); }
        LBAR();
#pragma unroll
        for (int s = 0; s < OT_PW; ++s) if (DRY != 1 && oti[s] >= 0) { const int tt = oti[s] & 1, vt = oti[s] >> 1;
            f32x16 o1, o2;
#pragma unroll
            for (int i = 0; i < 16; ++i) { o1[i] = 0.f; o2[i] = 0.f; }
            mma_tile<4>(o1, L + O_AIM, SJ, 32 * tt, L + O_VT, SJ, 32 * vt, r, h);
            mma_tile<DK / 16>(o2, L + O_QA, SQ, 32 * tt, L + O_STI, SQ, 32 * vt, r, h);
#pragma unroll
            for (int g = 0; g < 4; ++g) { f32x4 ev = {1.f, 1.f, 1.f, 1.f}; if (KIND != 2) ev = *(const LAS f32x4*)(ET + 32 * tt + 8 * g + 4 * h);
#pragma unroll
                for (int e = 0; e < 4; ++e) ohold[s][4 * g + e] = o1[4 * g + e] + ev[e] * o2[4 * g + e]; } }
        orow0 = row0;
        if (KIND != 2 && w == TW && c + 1 < NCH) SCAN_TABLES((c + 1) & 1);
        LBAR();
#pragma unroll
        for (int s = 0; s < ST_PW; ++s) if (sti[s] >= 0) { const int kt = sti[s] % NKT, vt = sti[s] / NKT; store_tile_T(st[s], L + O_STI, SQ, 32 * vt, 32 * kt, r, h); }
    }
    if (DRY == 0) SCAN_STORE_OUT();
#undef SCAN_PREFETCH
#undef SCAN_STORE_OUT
#undef SCAN_TABLES
    LBAR();
}
__device__ __forceinline__ void scan_phase(Frame& F, int l) {
    for (int t = blockIdx.x; t < 256; t += F.G) {
        if (PROBE & 262144) { if (t < 128) scan_chunked<0, 1>(F, l, t); else if (t < 192) scan_chunked<1, 1>(F, l, t - 128); else scan_chunked<2, 1>(F, l, t - 192); }
        if (PROBE & 524288) { if (t < 128) scan_chunked<0, 2>(F, l, t); else if (t < 192) scan_chunked<1, 2>(F, l, t - 128); else scan_chunked<2, 2>(F, l, t - 192); }
        if (t < 128) { scan_chunked<0>(F, l, t); if (PROBE & 8192) scan_chunked<0>(F, l, t); }
        else if (t < 192) { scan_chunked<1>(F, l, t - 128); if (PROBE & 16384) scan_chunked<1>(F, l, t - 128); }
        else { scan_chunked<2>(F, l, t - 192); if (PROBE & 32768) scan_chunked<2>(F, l, t - 192); }
    }
}
__device__ __forceinline__ void finish_phase(Frame& F, int l, int rows) {
    const bf16* P = (const bf16*)(F.ws + WS_BIG); const bf16* CV = (const bf16*)(F.ws + WS_CV); const bf16* Y0 = (const bf16*)(F.ws + WS_YS); const bf16* Y1 = Y0 + (size_t)M * D; bf16* ABR = (bf16*)(F.ws + WS_U);
    const float* DEN0 = (const float*)(F.ws + WS_DEN); const float* DEN1 = DEN0 + (size_t)M * 4;
    const float* dsk = F.in[I_SD] + l * 16; const float* snw = F.in[I_SNW] + l * 1024; const float* mnw = F.in[I_MNW] + l * 512; const float* gnw = F.in[I_GNW] + l * 512;
    for (int rr = F.gw; rr < rows; rr += 2 * F.NGW) {
        v2u ya[2][8], yb[2][8], xw[2][4], gw[2][8]; float dn0[2][2], dn1[2][2];
#pragma unroll
        for (int q = 0; q < 2; ++q) { const int r0_ = rr + q * F.NGW, r = r0_ < rows ? r0_ : rr;
#pragma unroll
            for (int j = 0; j < 8; ++j) { const int c = 256 * j + 4 * F.lane; ya[q][j] = *(const GAS v2u*)(Y0 + (size_t)r * D + c); yb[q][j] = *(const GAS v2u*)(Y1 + (size_t)r * D + c); }
#pragma unroll
            for (int j = 0; j < 4; ++j) { const int c = 256 * j + 4 * F.lane; xw[q][j] = *(const GAS v2u*)(CV + (size_t)r * CVW + c); gw[q][j] = *(const GAS v2u*)(P + (size_t)r * NWIDE + PC_Z + c); }
#pragma unroll
            for (int j = 0; j < 4; ++j) { const int cl = 256 * (j & 1) + 4 * F.lane; gw[q][4 + j] = *(const GAS v2u*)(P + (size_t)r * NWIDE + (j < 2 ? PC_MO : PC_GR) + cl); }
#pragma unroll
            for (int j = 0; j < 2; ++j) { const int hd_ = (256 * j + 4 * F.lane) >> 7; dn0[q][j] = DEN0[(size_t)r * 4 + hd_]; dn1[q][j] = DEN1[(size_t)r * 4 + hd_]; } }
#pragma unroll
        for (int q = 0; q < 2; ++q) { const int r = rr + q * F.NGW; if (r >= rows) continue;
#pragma unroll
            for (int j = 0; j < 4; ++j) { const int c = 256 * j + 4 * F.lane; const float ds = dsk[c >> 6];
                const v2u a = ya[q][j], b = yb[q][j], x = xw[q][j], z = gw[q][j];
                f32x4 y; y[0] = (bflo(a.x) + bflo(b.x) + ds * bflo(x.x)) * silu_f(bflo(z.x)); y[1] = (bfhi(a.x) + bfhi(b.x) + ds * bfhi(x.x)) * silu_f(bfhi(z.x));
                y[2] = (bflo(a.y) + bflo(b.y) + ds * bflo(x.y)) * silu_f(bflo(z.y)); y[3] = (bfhi(a.y) + bfhi(b.y) + ds * bfhi(x.y)) * silu_f(bfhi(z.y));
                const float ssq = wave_sum((y[0] * y[0] + y[1] * y[1]) + (y[2] * y[2] + y[3] * y[3])); const float rs = 1.f / sqrtf(ssq * (1.f / 256.f) + EPS);
                const f32x4 w = *(const GAS f32x4*)(snw + c); v2u o; o.x = pk2(y[0] * rs * w[0], y[1] * rs * w[1]); o.y = pk2(y[2] * rs * w[2], y[3] * rs * w[3]);
                *(GAS v2u*)(ABR + (size_t)r * D + c) = o; }
#pragma unroll
            for (int j = 0; j < 4; ++j) { const int cl = 256 * (j & 1) + 4 * F.lane, c = (j < 2 ? 1024 : 1536) + cl;
                const v2u a = ya[q][4 + j], b = yb[q][4 + j], g = gw[q][4 + j];
                f32x4 va = {bflo(a.x), bfhi(a.x), bflo(a.y), bfhi(a.y)}, vb = {bflo(b.x), bfhi(b.x), bflo(b.y), bfhi(b.y)};
                f32x4 y = va + vb;
                if (j < 2) { const float d0 = fmaxf(fabsf(dn0[q][j]), 1.0f), d1 = fmaxf(fabsf(dn1[q][j]), 1.0f); y = va / d0 + vb / d1;
                    y[0] *= sigm_f(bflo(g.x)); y[1] *= sigm_f(bfhi(g.x)); y[2] *= sigm_f(bflo(g.y)); y[3] *= sigm_f(bfhi(g.y)); }
                const float mean = half_sum((y[0] + y[1]) + (y[2] + y[3])) * (1.f / 128.f); y = y - mean;
                const float var = half_sum((y[0] * y[0] + y[1] * y[1]) + (y[2] * y[2] + y[3] * y[3])) * (1.f / 128.f); const float rs = 1.f / sqrtf(var + EPS);
                const f32x4 w = *(const GAS f32x4*)((j < 2 ? mnw : gnw) + cl); y = y * rs * w;
                if (j >= 2) { y[0] *= silu_f(bflo(g.x)); y[1] *= silu_f(bfhi(g.x)); y[2] *= silu_f(bflo(g.y)); y[3] *= silu_f(bfhi(g.y)); }
                v2u o; o.x = pk2(y[0], y[1]); o.y = pk2(y[2], y[3]); *(GAS v2u*)(ABR + (size_t)r * D + c) = o; } }
    }
}

constexpr int PH_PER_LAYER = 13, N_PHASES = 2 + PH_PER_LAYER * DEPTH;
__global__ void __launch_bounds__(NWAVES * 64, 2) mk_fwd(Args args) {
    extern __shared__ __attribute__((aligned(16))) unsigned char lds_[];
    LAS unsigned char* lds = (LAS unsigned char*)lds_;
    volatile LAS unsigned* MISC = (volatile LAS unsigned*)(lds + MISC_OFF);
    for (int u = threadIdx.x; u < (LDS_BYTES - LDSCTL_OFF) / 4; u += NWAVES * 64) ((LAS unsigned*)(lds + LDSCTL_OFF))[u] = 0u;
    __syncthreads();
    XcdBarrier bar; bar.bar = (unsigned*)(args.ws + WS_CTL) + CW_BAR; bar.x = 0; bar.st = nullptr;
    if (!MK_PER_PHASE) bar = xcd_barrier_post((unsigned*)(args.ws + WS_CTL) + CW_BAR, MISC + 8);
    const int lo = args.ph_lo, hi = args.ph_hi;
#define IN(k) (lo <= (k) && (k) < hi)
#define SEAM(k) do { if (IN(k) && IN((k) + 1)) { xcd_barrier(bar); if (PROBE & 131072) xcd_barrier(bar); } } while (0)
    unsigned long long pt_acc = 0, pt_t0 = 0, blk_t0 = 0;
#define PB0(k) do { if (PROBE_BLK == (k) && threadIdx.x == 0) blk_t0 = wall_clock64(); } while (0)
#define PB1(k) do { if (PROBE_BLK == (k) && threadIdx.x == 0) __hip_atomic_store((unsigned*)(args.ws + WS_CTL) + 65536 + blockIdx.x, (unsigned)(wall_clock64() - blk_t0), __ATOMIC_RELAXED, __HIP_MEMORY_SCOPE_AGENT); } while (0)
#define PB2(k) do { if (PROBE_BLK == (k)) { if (blockIdx.x == 0 && threadIdx.x == 0) { unsigned mx = 0, mn = 0xffffffffu; unsigned long long sm = 0; \
        for (int i_ = 0; i_ < (int)gridDim.x; ++i_) { const unsigned v = __hip_atomic_load((unsigned*)(args.ws + WS_CTL) + 65536 + i_, __ATOMIC_RELAXED, __HIP_MEMORY_SCOPE_AGENT); mx = v > mx ? v : mx; mn = v < mn ? v : mn; sm += v; } \
        const unsigned long long wait = PROBE_BSTAT == 1 ? mx : (PROBE_BSTAT == 2 ? mn : sm / gridDim.x); const unsigned long long t0 = wall_clock64(); while (wall_clock64() - t0 < wait) __builtin_amdgcn_s_sleep(8); } __syncthreads(); } } while (0)
#define PT0(ty) do { if (PROBE_T == (ty) && blockIdx.x == 0 && threadIdx.x == 0) pt_t0 = wall_clock64(); } while (0)
#define PT1(ty) do { if (PROBE_T == (ty) && blockIdx.x == 0 && threadIdx.x == 0) pt_acc += wall_clock64() - pt_t0; } while (0)
#define GEMM_CALL(EPI, Aptr, Bptr, Mr, Nn, Kk, LDA, LDB, ...) do { pg8::Gemm g{Aptr, Bptr, Mr, Nn, Kk, LDA, LDB}; pg8::StaticOrder S; S.init(Mr, Nn, F.G, (int)blockIdx.x); EPI E{__VA_ARGS__}; \
        pg8::gemm_phase<EPI, pg8::StaticOrder, PG8_ALIGN, PG8_SP2>(F.lds + RING_OFF, g, S, E); } while (0)
#define PIECE_CALL(Aptr, Bptr, Mr, Nn, Kslice, LDA, LDB, KS, ...) do { pg8::Gemm g{Aptr, Bptr, Mr, Nn, Kslice, LDA, LDB}; pg8::PieceOrder S; S.init(Mr, Nn, KS, (Kslice) * 2, F.G, (int)blockIdx.x); pg8::EpiF32Part E{__VA_ARGS__}; \
        pg8::gemm_phase<pg8::EpiF32Part, pg8::PieceOrder, PG8_ALIGN, PG8_SP2>(F.lds + RING_OFF, g, S, E); } while (0)
#if PROBE & 4194304
#define PROBE_SCHED pg8::HotOrder
#else
#define PROBE_SCHED pg8::StaticOrder
#endif
#define REP(bit) for (int rep_ = 0; rep_ < ((PROBE & (bit)) ? 2 : 1); ++rep_)
#define WSP(T, off) ((T*)(F.ws + (off)))

    PT0(10); if (IN(0)) { REP(128) { Frame F = mkframe(lds); mod_phase(F); } REP(8) { Frame F = mkframe(lds); convert_weights(F, 0); __syncthreads(); } } SEAM(0); PT1(10);
    PT0(11); if (IN(1)) { Frame F = mkframe(lds); modulate_rows(F, 0, 0, M); } SEAM(1); PT1(11);
    for (int l = 0; l < DEPTH; ++l) {
        const int pb = 2 + PH_PER_LAYER * l;
        const bool lastl = (l == DEPTH - 1);
        const int Mtail = lastl ? ML : M;
        unsigned long long pc0_ = 0, pr0_ = 0, pb0_ = 0;
        if ((PROBE & 16777216) && l == ((PROBE & 134217728) ? 1 : 0) && threadIdx.x == 0) pb0_ = wall_clock64();
        if ((PROBE & 1048576) && l == ((PROBE & 134217728) ? 1 : 0) && blockIdx.x == 0 && threadIdx.x == 0) { pc0_ = clock64(); pr0_ = wall_clock64(); }
        PB0(pb + 0);
        PT0(1);
        if (IN(pb + 0)) { if (PROBE & 65536) { Frame F = mkframe(lds); pg8::Gemm g{WSP(bf16, WS_U), WSP(bf16, WS_WB + WB_FIN), M, NFF, D, D, D}; PROBE_SCHED S; S.init(M, NFF, F.G, (int)blockIdx.x); pg8::EpiNull E{0};
            pg8::gemm_phase<pg8::EpiNull, PROBE_SCHED, PG8_ALIGN, PG8_SP2>(F.lds + RING_OFF, g, S, E); } REP(256) { Frame F = mkframe(lds); GEMM_CALL(pg8::EpiSwiGLU, WSP(bf16, WS_U), WSP(bf16, WS_WB + WB_FIN), M, NFF, D, D, D, WSP(bf16, WS_BIG), DFF); } }
        if ((PROBE & 1048576) && l == ((PROBE & 134217728) ? 1 : 0)) {
            if (blockIdx.x == 0 && threadIdx.x == 0) { const unsigned long long c1 = clock64(), r1 = wall_clock64(); const unsigned long long wait = (PROBE & 2097152) ? 100000ull : ((PROBE & 8388608) ? (c1 - pc0_) * 30ull / 384ull : (c1 - pc0_) * 5000ull / (r1 - pr0_)); const unsigned long long t0 = wall_clock64(); while (wall_clock64() - t0 < wait) __builtin_amdgcn_s_sleep(8); }
            __syncthreads(); }
        if ((PROBE & 16777216) && l == ((PROBE & 134217728) ? 1 : 0)) { if (threadIdx.x == 0) __hip_atomic_store((unsigned*)(args.ws + WS_CTL) + 65536 + blockIdx.x, (unsigned)(wall_clock64() - pb0_), __ATOMIC_RELAXED, __HIP_MEMORY_SCOPE_AGENT); }
        PB1(pb + 0); SEAM(pb + 0); PB2(pb + 0); PT1(1);
        if ((PROBE & 16777216) && l == ((PROBE & 134217728) ? 1 : 0)) { if (blockIdx.x == 0 && threadIdx.x == 0) { unsigned mx = 0, mn = 0xffffffffu; unsigned long long sm = 0;
                for (int i = 0; i < (int)gridDim.x; ++i) { const unsigned v = __hip_atomic_load((unsigned*)(args.ws + WS_CTL) + 65536 + i, __ATOMIC_RELAXED, __HIP_MEMORY_SCOPE_AGENT); mx = v > mx ? v : mx; mn = v < mn ? v : mn; sm += v; }
                const unsigned long long wait = (PROBE & 33554432) ? mx : ((PROBE & 67108864) ? mn : sm / gridDim.x); const unsigned long long t0 = wall_clock64(); while (wall_clock64() - t0 < wait) __builtin_amdgcn_s_sleep(8); }
            __syncthreads(); }
        PB0(pb + 1);
        PT0(2);
        if (IN(pb + 1)) REP(512) { { Frame F = mkframe(lds); GEMM_CALL(pg8::EpiBf16, WSP(bf16, WS_BIG), WSP(bf16, WS_WB + WB_FOUT), ML, D, DFF, DFF, DFF, WSP(bf16, WS_Y), D); }
            { Frame F = mkframe(lds); PIECE_CALL(WSP(bf16, WS_BIG) + (size_t)ML * DFF, WSP(bf16, WS_WB + WB_FOUT), MC, D, DFF / 4, DFF, DFF, 4, WSP(float, WS_YP), D, (size_t)MC * D); } } PB1(pb + 1); SEAM(pb + 1); PB2(pb + 1); PT1(2);
        PB0(pb + 2);
        PT0(7);
        if (IN(pb + 2)) { if (PROBE & 16) { Frame F = mkframe(lds); ln_rows(F, l, 0, 0.5f, l == 0, 0, l, 1, true, false, M, true, true); } Frame F = mkframe(lds); ln_rows(F, l, 0, 0.5f, l == 0, 0, l, 1, true, false, M, false, true); } PB1(pb + 2); SEAM(pb + 2); PB2(pb + 2); PT1(7);
        PB0(pb + 3);
        PT0(3);
        if (IN(pb + 3)) REP(1024) { Frame F = mkframe(lds); const int NA = (M / 256) * 17, nbx = (F.G - NA % F.G) % F.G;
            pg8::Gemm g{WSP(bf16, WS_U), WSP(bf16, WS_WB + WB_WIN), M, NIN, D, D, D}; pg8::InProjAOrder S; S.init(M, Mtail, nbx, F.G, (int)blockIdx.x); pg8::EpiInProj E{WSP(bf16, WS_BIG), NWIDE, WSP(float, WS_PN), NWIDE / 256};
            pg8::gemm_phase<pg8::EpiInProj, pg8::InProjAOrder, PG8_ALIGN, PG8_SP2>(F.lds + RING_OFF, g, S, E); } PB1(pb + 3); SEAM(pb + 3); PB2(pb + 3); PT1(3);
        PB0(pb + 4);
        PT0(8);
        if (IN(pb + 4)) { if (PROBE & 4) { Frame F = mkframe(lds); prep_phase(F, l, 1); } if (PROBE & 32) { Frame F = mkframe(lds); prep_phase(F, l, 2); } Frame F = mkframe(lds); prep_phase(F, l); } PB1(pb + 4); SEAM(pb + 4); PB2(pb + 4); PT1(8);
        PB0(pb + 5);
        PT0(6);
        if (IN(pb + 5)) { REP(1) { Frame F = mkframe(lds); scan_phase(F, l); }
            { Frame F = mkframe(lds); const int NA = (M / 256) * 17, nbx = (F.G - NA % F.G) % F.G;
              pg8::Gemm g{WSP(bf16, WS_U), WSP(bf16, WS_WB + WB_WIN), M, NIN, D, D, D}; pg8::InProjBOrder S; S.init(Mtail, nbx, lastl ? 9 : 10, 6, 7, F.G, (int)blockIdx.x); pg8::EpiInProj E{WSP(bf16, WS_BIG), NWIDE, WSP(float, WS_PN), NWIDE / 256};
              pg8::gemm_phase<pg8::EpiInProj, pg8::InProjBOrder, PG8_ALIGN, PG8_SP2>(F.lds + RING_OFF, g, S, E); } } PB1(pb + 5); SEAM(pb + 5); PB2(pb + 5); PT1(6);
        PB0(pb + 6);
        PT0(9);
        if (IN(pb + 6)) REP(64) { Frame F = mkframe(lds); finish_phase(F, l, Mtail); } PB1(pb + 6); SEAM(pb + 6); PB2(pb + 6); PT1(9);
        PB0(pb + 7);
        PT0(4);
        if (IN(pb + 7)) REP(2048) { Frame F = mkframe(lds); const float* mb = F.in[I_MERGEB] + (size_t)l * 3 * D;
            pg8::Gemm g{WSP(bf16, WS_U), WSP(bf16, WS_WB + WB_BRS), Mtail, D, D, D, D}; pg8::SegOrder S; S.init(Mtail, D, F.G, (int)blockIdx.x); pg8::EpiBranchSeg E{WSP(bf16, WS_BIG) + PC_GATE, NWIDE, mb, WSP(bf16, WS_YS), WSP(bf16, WS_CV), D};
            pg8::gemm_phase<pg8::EpiBranchSeg, pg8::SegOrder, PG8_ALIGN, PG8_SP2>(F.lds + RING_OFF, g, S, E); } PB1(pb + 7); SEAM(pb + 7); PB2(pb + 7); PT1(4);
        PB0(pb + 8);
        PT0(5);
        if (IN(pb + 8)) REP(4096) { { Frame F = mkframe(lds); GEMM_CALL(pg8::EpiBf16, WSP(bf16, WS_CV), WSP(bf16, WS_WB + WB_OUT), ML, D, D, D, D, WSP(bf16, WS_Y), D); }
            if (!lastl) { Frame F = mkframe(lds); PIECE_CALL(WSP(bf16, WS_CV) + (size_t)ML * D, WSP(bf16, WS_WB + WB_OUT), MC, D, D / 4, D, D, 4, WSP(float, WS_YP), D, (size_t)MC * D); } } PB1(pb + 8); SEAM(pb + 8); PB2(pb + 8); PT1(5);
        PB0(pb + 9);
        PT0(7);
        if (IN(pb + 9)) { if (PROBE & 16) { Frame F = mkframe(lds); ln_rows(F, l, 1, 1.0f, false, 1, l, 2, true, false, Mtail, true, true); } Frame F = mkframe(lds); ln_rows(F, l, 1, 1.0f, false, 1, l, 2, true, false, Mtail, false, true); } PB1(pb + 9); SEAM(pb + 9); PB2(pb + 9); PT1(7);
        PB0(pb + 10);
        PT0(1);
        if (IN(pb + 10)) REP(256) { Frame F = mkframe(lds); GEMM_CALL(pg8::EpiSwiGLU, WSP(bf16, WS_U), WSP(bf16, WS_WB + WB_FIN) + (size_t)NFF * D, Mtail, NFF, D, D, D, WSP(bf16, WS_BIG), DFF); } PB1(pb + 10); SEAM(pb + 10); PB2(pb + 10); PT1(1);
        PB0(pb + 11);
        PT0(2);
        if (IN(pb + 11)) REP(512) { { Frame F = mkframe(lds); GEMM_CALL(pg8::EpiBf16, WSP(bf16, WS_BIG), WSP(bf16, WS_WB + WB_FOUT) + (size_t)D * DFF, ML, D, DFF, DFF, DFF, WSP(bf16, WS_Y), D); }
            if (!lastl) { Frame F = mkframe(lds); PIECE_CALL(WSP(bf16, WS_BIG) + (size_t)ML * DFF, WSP(bf16, WS_WB + WB_FOUT) + (size_t)D * DFF, MC, D, DFF / 4, DFF, DFF, 4, WSP(float, WS_YP), D, (size_t)MC * D); } } PB1(pb + 11); SEAM(pb + 11); PB2(pb + 11); PT1(2);
        PB0(pb + 12);
        PT0(7);
        if (IN(pb + 12)) { if (PROBE & 16) { Frame F = mkframe(lds); ln_rows(F, l, 2, 0.5f, false, 2, lastl ? l : l + 1, 0, !lastl, lastl, Mtail, true, true); } Frame F = mkframe(lds); ln_rows(F, l, 2, 0.5f, false, 2, lastl ? l : l + 1, 0, !lastl, lastl, Mtail, false, true);
            if (!lastl) REP(8) { convert_weights(F, l + 1); __syncthreads(); } } PB1(pb + 12); SEAM(pb + 12); PB2(pb + 12); PT1(7);
    }
    if (PROBE_T != 0) { if (blockIdx.x == 0 && threadIdx.x == 0) { const unsigned long long t0 = wall_clock64(); while (wall_clock64() - t0 < pt_acc) __builtin_amdgcn_s_sleep(8); } __syncthreads(); }
#undef IN
#undef SEAM
}

extern "C" void kernel_launch(void* const* d_in, const int* in_sizes, int n_in, void* d_out, int out_size, void* d_ws, size_t ws_size, hipStream_t stream) {
    static int grid = 0;
    if (grid == 0) {
        if (n_in != 29 || in_sizes[0] != ML * D || out_size != ML * D || ws_size < WS_END) { fprintf(stderr, "kernel_launch: unexpected shapes (n_in %d, out %d, ws %zu, need %zu); nothing launched\n", n_in, out_size, ws_size, (size_t)WS_END); grid = -1; return; }
        int dev = 0, cus = 0, per_cu = 0;
        if (hipGetDevice(&dev) != hipSuccess || hipDeviceGetAttribute(&cus, hipDeviceAttributeMultiprocessorCount, dev) != hipSuccess) { fprintf(stderr, "kernel_launch: device query failed\n"); grid = -1; return; }
        if (hipFuncSetAttribute((const void*)mk_fwd, hipFuncAttributeMaxDynamicSharedMemorySize, LDS_BYTES) != hipSuccess) { fprintf(stderr, "kernel_launch: hipFuncSetAttribute failed\n"); grid = -1; return; }
        if (hipOccupancyMaxActiveBlocksPerMultiprocessor(&per_cu, (const void*)mk_fwd, NWAVES * 64, LDS_BYTES) != hipSuccess || per_cu < 1)
            fprintf(stderr, "kernel_launch: note: occupancy query reports %d workgroups per CU\n", per_cu);
        (void)hipGetLastError();
        grid = cus;
    }
    if (grid < 0) return;
    if (hipMemsetAsync((char*)d_ws + WS_CTL, 0, CTL_ZERO_BYTES, stream) != hipSuccess) { fprintf(stderr, "kernel_launch: memset failed\n"); return; }
    Args a{};
    for (int i = 0; i < 29; ++i) a.in[i] = (const float*)d_in[i];
    a.out = (float*)d_out; a.ws = (unsigned char*)d_ws;
#if MK_PER_PHASE
    for (int ph = 0; ph < N_PHASES; ++ph) { a.ph_lo = ph; a.ph_hi = ph + 1; hipLaunchKernelGGL(mk_fwd, dim3(grid), dim3(NWAVES * 64), LDS_BYTES, stream, a); }
#else
    a.ph_lo = 0; a.ph_hi = N_PHASES;
    hipLaunchKernelGGL(mk_fwd, dim3(grid), dim3(NWAVES * 64), LDS_BYTES, stream, a);
#endif
    const hipError_t le = hipPeekAtLastError();
    if (le != hipSuccess) fprintf(stderr, "kernel_launch: launch failed: %s\n", hipGetErrorName(le));
}
```
